# Optimizing an MI355X kernel written in HIP

```python
import math
import jax, jax.numpy as jnp
from jax import lax
import numpy as np

D_MODEL = 2048
BATCH = 2
SEQ = 4096
DEPTH = 4

HEAD_DIM = 64
Q_BLOCK = 128
RMS_EPS = 1e-6
MASK_VALUE = -1e30
ALIBI_MAX_EXP = 8.0
FOX_HEADS = 7
NSA_HEADS = 8
NSA_KV_GROUPS = 2
NSA_CMP_LEN = 32
NSA_CMP_STRIDE = 16
NSA_SEL_BLOCK = 64
NSA_TOP_N = 16
NSA_WINDOW = 512
NSA_FORCE_SCORE = 1e4
DIL_CONFIGS = ((128, 1), (512, 4), (2048, 16))
DIL_HEADS_PER_GROUP = 3
DIL_HEADS = DIL_HEADS_PER_GROUP * len(DIL_CONFIGS)
DIFF_HEADS = 4
DIFF_QK_DIM = 64
DIFF_V_DIM = 2 * DIFF_QK_DIM
MIX_WIDTH = (FOX_HEADS + NSA_HEADS + DIL_HEADS) * HEAD_DIM + DIFF_HEADS * DIFF_V_DIM
D_FF = ((8 * D_MODEL + 3 * 256 - 1) // (3 * 256)) * 256
NSA_KV = NSA_KV_GROUPS * HEAD_DIM
IN_SPLITS = (
    ('fox_q', FOX_HEADS * HEAD_DIM), ('fox_k', FOX_HEADS * HEAD_DIM), ('fox_v', FOX_HEADS * HEAD_DIM), ('fox_f', FOX_HEADS),
    ('nsa_q', NSA_HEADS * HEAD_DIM),
    ('nsa_cmp_k', NSA_KV), ('nsa_cmp_v', NSA_KV), ('nsa_slc_k', NSA_KV), ('nsa_slc_v', NSA_KV), ('nsa_win_k', NSA_KV), ('nsa_win_v', NSA_KV),
    ('nsa_gate', NSA_HEADS * 3),
    ('dil_q', DIL_HEADS * HEAD_DIM), ('dil_k', DIL_HEADS * HEAD_DIM), ('dil_v', DIL_HEADS * HEAD_DIM),
    ('diff_q', DIFF_HEADS * 2 * DIFF_QK_DIM), ('diff_k', DIFF_HEADS * 2 * DIFF_QK_DIM), ('diff_v', DIFF_HEADS * DIFF_V_DIM),
)
N_IN = sum(w for _, w in IN_SPLITS)

kernel_name = 'hybrid_parallel_head_decoder'


def rms_norm(x, gain):
    xf = x.astype(jnp.float32)
    y = xf * lax.rsqrt(jnp.mean(xf * xf, axis=-1, keepdims=True) + RMS_EPS)
    return (y * gain.astype(jnp.float32)).astype(x.dtype)


def masked_softmax(s, mask):
    p = jax.nn.softmax(jnp.where(mask, s, MASK_VALUE), axis=-1)
    return jnp.where(mask, p, 0.0)


def alibi_slopes(n_heads):
    return jnp.asarray(2.0 ** (-ALIBI_MAX_EXP * np.arange(1, n_heads + 1) / n_heads), jnp.float32)


def blocks_to_seq(o):
    o = jnp.moveaxis(o, 0, 1)
    return o.reshape(o.shape[0], o.shape[1] * o.shape[2], *o.shape[3:])


def fox_attention(q, k, v, f_logit, f_bias):
    B, S, H, dh = q.shape
    scale = dh ** -0.5
    log_f = jax.nn.log_sigmoid(f_logit.astype(jnp.float32) + f_bias.astype(jnp.float32))
    cum = jnp.cumsum(log_f, axis=1).transpose(0, 2, 1)
    pos = jnp.arange(S)

    def block(i):
        qs = i * Q_BLOCK
        tq = qs + jnp.arange(Q_BLOCK)
        qb = lax.dynamic_slice_in_dim(q, qs, Q_BLOCK, 1)
        cq = lax.dynamic_slice_in_dim(cum, qs, Q_BLOCK, 2)
        s = jnp.einsum('bqhd,bkhd->bhqk', qb, k).astype(jnp.float32) * scale
        s = s + cq[..., None] - cum[:, :, None, :]
        p = jax.nn.softmax(jnp.where(pos[None, :] <= tq[:, None], s, MASK_VALUE), axis=-1)
        return jnp.einsum('bhqk,bkhd->bqhd', p.astype(v.dtype), v)

    o = blocks_to_seq(lax.map(block, jnp.arange(S // Q_BLOCK)))
    return o.reshape(B, S, H * dh)


def cmp_to_sel_matrix(n_cmp, n_sel):
    a = NSA_SEL_BLOCK // NSA_CMP_STRIDE
    b = NSA_CMP_LEN // NSA_CMP_STRIDE
    j = np.arange(n_sel)[:, None, None]
    idx = a * j + np.arange(a)[None, :, None] - np.arange(b)[None, None, :]
    jj = np.broadcast_to(j, idx.shape)
    ok = (idx >= 0) & (idx < n_cmp)
    m = np.zeros((n_cmp, n_sel), np.float32)
    np.add.at(m, (idx[ok], jj[ok]), 1.0)
    return m


def nsa_attention(q, k_cmp, v_cmp, k_slc, v_slc, k_win, v_win, gate_logit, cmp_w1, cmp_w2, cmp_pos):
    B, S, H, dh = q.shape
    G = k_cmp.shape[2]
    hpg = H // G
    scale = dh ** -0.5
    slopes = alibi_slopes(H).reshape(G, hpg)[None, :, :, None, None]
    ratio = NSA_CMP_LEN // NSA_CMP_STRIDE
    n_chunk = S // NSA_CMP_STRIDE
    n_cmp = n_chunk - ratio + 1
    n_sel = S // NSA_SEL_BLOCK
    n_top = min(NSA_TOP_N, n_sel)

    def compress(t, w1, w2, pos_emb):
        ch = t.reshape(B, n_chunk, NSA_CMP_STRIDE, G, dh)
        blk = jnp.concatenate([ch[:, r:r + n_cmp] for r in range(ratio)], axis=2)
        blk = (blk + pos_emb[:, None, :]).transpose(0, 1, 3, 2, 4).reshape(B, n_cmp, G, NSA_CMP_LEN * dh)
        return jax.nn.gelu(blk @ w1) @ w2

    kc = compress(k_cmp, cmp_w1[0], cmp_w2[0], cmp_pos[0])
    vc = compress(v_cmp, cmp_w1[1], cmp_w2[1], cmp_pos[1])
    cmp_end = jnp.arange(n_cmp) * NSA_CMP_STRIDE + (NSA_CMP_LEN - 1)
    cmp_to_sel = jnp.asarray(cmp_to_sel_matrix(n_cmp, n_sel), jnp.float32)
    k_blocks = k_slc.transpose(0, 2, 1, 3).reshape(B, G, n_sel, NSA_SEL_BLOCK, dh)
    v_blocks = v_slc.transpose(0, 2, 1, 3).reshape(B, G, n_sel, NSA_SEL_BLOCK, dh)
    pad = ((0, 0), (NSA_WINDOW, 0), (0, 0), (0, 0))
    k_win_p = jnp.pad(k_win, pad)
    v_win_p = jnp.pad(v_win, pad)
    gates = jax.nn.sigmoid(gate_logit).reshape(B, S, G, hpg, 3)
    sel_ids = jnp.arange(n_sel)
    win_offsets = jnp.arange(Q_BLOCK + NSA_WINDOW) - NSA_WINDOW
    sel_offsets = jnp.arange(NSA_SEL_BLOCK)

    def block(i):
        qs = i * Q_BLOCK
        tq = qs + jnp.arange(Q_BLOCK)
        qb = lax.dynamic_slice_in_dim(q, qs, Q_BLOCK, 1).reshape(B, Q_BLOCK, G, hpg, dh)
        dist_c = (tq[:, None] - cmp_end[None, :]).astype(jnp.float32)
        s_c = jnp.einsum('bqgjd,bcgd->bgjqc', qb, kc).astype(jnp.float32) * scale - slopes * dist_c
        p_c = masked_softmax(s_c, dist_c >= 0)
        o_c = jnp.einsum('bgjqc,bcgd->bqgjd', p_c.astype(vc.dtype), vc)
        imp = jnp.einsum('bgjqc,cn->bgqn', p_c, cmp_to_sel)
        cur = (tq // NSA_SEL_BLOCK)[:, None]
        forced = (sel_ids == 0) | (sel_ids == cur) | (sel_ids == cur - 1)
        causal = sel_ids * NSA_SEL_BLOCK <= tq[:, None]
        score = jnp.where(causal, jnp.where(forced, NSA_FORCE_SCORE, imp), MASK_VALUE)
        _, top_idx = lax.top_k(score, n_top)
        flat = top_idx.reshape(B, G, Q_BLOCK * n_top)[..., None, None]
        ks = jnp.take_along_axis(k_blocks, flat, axis=2).reshape(B, G, Q_BLOCK, n_top * NSA_SEL_BLOCK, dh)
        vs = jnp.take_along_axis(v_blocks, flat, axis=2).reshape(B, G, Q_BLOCK, n_top * NSA_SEL_BLOCK, dh)
        kpos = (top_idx[..., None] * NSA_SEL_BLOCK + sel_offsets).reshape(B, G, Q_BLOCK, n_top * NSA_SEL_BLOCK)
        dist_s = (tq[:, None] - kpos).astype(jnp.float32)[:, :, None]
        s_s = jnp.einsum('bqgjd,bgqkd->bgjqk', qb, ks).astype(jnp.float32) * scale - slopes * dist_s
        p_s = masked_softmax(s_s, dist_s >= 0)
        o_s = jnp.einsum('bgjqk,bgqkd->bqgjd', p_s.astype(vs.dtype), vs)
        kw = lax.dynamic_slice_in_dim(k_win_p, qs, Q_BLOCK + NSA_WINDOW, 1)
        vw = lax.dynamic_slice_in_dim(v_win_p, qs, Q_BLOCK + NSA_WINDOW, 1)
        kpos_w = qs + win_offsets
        dist_w = tq[:, None] - kpos_w[None, :]
        mask_w = (dist_w >= 0) & (dist_w < NSA_WINDOW) & (kpos_w[None, :] >= 0)
        s_w = jnp.einsum('bqgjd,bkgd->bgjqk', qb, kw).astype(jnp.float32) * scale - slopes * dist_w.astype(jnp.float32)
        p_w = masked_softmax(s_w, mask_w)
        o_w = jnp.einsum('bgjqk,bkgd->bqgjd', p_w.astype(vw.dtype), vw)
        g = lax.dynamic_slice_in_dim(gates, qs, Q_BLOCK, 1)
        return g[..., 0:1] * o_c + g[..., 1:2] * o_s + g[..., 2:3] * o_w

    o = blocks_to_seq(lax.map(block, jnp.arange(S // Q_BLOCK)))
    return o.reshape(B, S, H * dh)


def dilated_attention(q, k, v):
    B, S, H, dh = q.shape
    scale = dh ** -0.5
    slopes = alibi_slopes(H)
    hpg = DIL_HEADS_PER_GROUP
    k_groups = [k[:, :, g * hpg:(g + 1) * hpg] for g in range(len(DIL_CONFIGS))]
    v_groups = [v[:, :, g * hpg:(g + 1) * hpg] for g in range(len(DIL_CONFIGS))]

    def block(i):
        qs = i * Q_BLOCK
        tq = qs + jnp.arange(Q_BLOCK)
        qb = lax.dynamic_slice_in_dim(q, qs, Q_BLOCK, 1)
        outs, lses = [], []
        for g, (window, dilation) in enumerate(DIL_CONFIGS):
            steps = jnp.arange(window // dilation + 1) * dilation
            kidx = tq[:, None] - steps[None, :]
            valid = kidx >= 0
            kidx = jnp.maximum(kidx, 0)
            kg = k_groups[g][:, kidx]
            vg = v_groups[g][:, kidx]
            s = jnp.einsum('bqhd,bqkhd->bhqk', qb[:, :, g * hpg:(g + 1) * hpg], kg).astype(jnp.float32) * scale
            s = s - slopes[g * hpg:(g + 1) * hpg][:, None, None] * steps.astype(jnp.float32)
            s = jnp.where(valid, s, MASK_VALUE)
            lse = jax.nn.logsumexp(s, axis=-1)
            p = jnp.exp(s - lse[..., None])
            outs.append(jnp.einsum('bhqk,bqkhd->bqhd', p.astype(vg.dtype), vg))
            lses.append(lse)
        w = jax.nn.softmax(jnp.stack(lses, axis=0), axis=0).transpose(0, 1, 3, 2)[..., None]
        return jnp.concatenate([o * w[g].astype(o.dtype) for g, o in enumerate(outs)], axis=2)

    o = blocks_to_seq(lax.map(block, jnp.arange(S // Q_BLOCK)))
    return o.reshape(B, S, H * dh)


def diff_attention(q, k, v, lam_vecs, subln_g, lam_init):
    B, S, H, _, dq = q.shape
    dv = v.shape[-1]
    scale = dq ** -0.5
    lv = lam_vecs.astype(jnp.float32)
    lam = jnp.exp(jnp.sum(lv[0] * lv[1])) - jnp.exp(jnp.sum(lv[2] * lv[3])) + lam_init
    slopes = alibi_slopes(H)[None, :, None, None, None]
    pos = jnp.arange(S)

    def block(i):
        qs = i * Q_BLOCK
        tq = qs + jnp.arange(Q_BLOCK)
        qb = lax.dynamic_slice_in_dim(q, qs, Q_BLOCK, 1)
        dist = tq[:, None] - pos[None, :]
        s = jnp.einsum('bqhmd,bkhmd->bhmqk', qb, k).astype(jnp.float32) * scale - slopes * dist.astype(jnp.float32)
        p = jax.nn.softmax(jnp.where(dist >= 0, s, MASK_VALUE), axis=-1)
        a = p[:, :, 0] - lam * p[:, :, 1]
        return jnp.einsum('bhqk,bkhd->bqhd', a.astype(v.dtype), v)

    o = blocks_to_seq(lax.map(block, jnp.arange(S // Q_BLOCK)))
    o = rms_norm(o, subln_g) * (1.0 - lam_init)
    return o.reshape(B, S, H * dv)


def hybrid_mixer(u, w_in, fox_f_bias, cmp_w1, cmp_w2, cmp_pos, diff_lambda, diff_subln_g, diff_lam_init, w_out):
    B, S, _ = u.shape
    proj = u @ w_in
    offsets = [int(o) for o in np.cumsum([w for _, w in IN_SPLITS])[:-1]]
    p = dict(zip([n for n, _ in IN_SPLITS], jnp.split(proj, offsets, axis=-1)))

    def hd(name, *shape):
        return p[name].reshape(B, S, *shape)

    o_fox = fox_attention(hd('fox_q', FOX_HEADS, HEAD_DIM), hd('fox_k', FOX_HEADS, HEAD_DIM),
                          hd('fox_v', FOX_HEADS, HEAD_DIM), p['fox_f'], fox_f_bias)
    o_nsa = nsa_attention(hd('nsa_q', NSA_HEADS, HEAD_DIM),
                          hd('nsa_cmp_k', NSA_KV_GROUPS, HEAD_DIM), hd('nsa_cmp_v', NSA_KV_GROUPS, HEAD_DIM),
                          hd('nsa_slc_k', NSA_KV_GROUPS, HEAD_DIM), hd('nsa_slc_v', NSA_KV_GROUPS, HEAD_DIM),
                          hd('nsa_win_k', NSA_KV_GROUPS, HEAD_DIM), hd('nsa_win_v', NSA_KV_GROUPS, HEAD_DIM),
                          hd('nsa_gate', NSA_HEADS, 3), cmp_w1, cmp_w2, cmp_pos)
    o_dil = dilated_attention(hd('dil_q', DIL_HEADS, HEAD_DIM), hd('dil_k', DIL_HEADS, HEAD_DIM),
                              hd('dil_v', DIL_HEADS, HEAD_DIM))
    o_diff = diff_attention(hd('diff_q', DIFF_HEADS, 2, DIFF_QK_DIM), hd('diff_k', DIFF_HEADS, 2, DIFF_QK_DIM),
                            hd('diff_v', DIFF_HEADS, DIFF_V_DIM), diff_lambda, diff_subln_g, diff_lam_init)
    o = jnp.concatenate([o_fox, o_nsa, o_dil, o_diff], axis=-1)
    return o @ w_out


def swiglu(u, w_gate, w_up, w_down):
    return (jax.nn.silu(u @ w_gate) * (u @ w_up)) @ w_down


def setup_inputs(seed: int = 0) -> dict:
    key = jax.random.key(seed)
    ks = jax.random.split(key, 18)
    D = D_MODEL

    def nrm(k, shape, scale):
        return jax.random.normal(k, shape, jnp.float32) * scale

    return {
        'x': nrm(ks[0], (BATCH, SEQ, D), 1.0),
        'c': nrm(ks[1], (BATCH, D), 1.0),
        'ada_w': nrm(ks[2], (DEPTH, D, 6 * D), 0.5 * D ** -0.5),
        'ada_b': nrm(ks[3], (DEPTH, 6 * D), 0.02),
        'norm_mix_g': 1.0 + nrm(ks[4], (DEPTH, D), 0.02),
        'norm_ffn_g': 1.0 + nrm(ks[5], (DEPTH, D), 0.02),
        'w_in': nrm(ks[6], (DEPTH, D, N_IN), D ** -0.5),
        'fox_f_bias': 3.0 + nrm(ks[7], (DEPTH, FOX_HEADS), 0.5),
        'nsa_cmp_w1': nrm(ks[8], (DEPTH, 2, NSA_CMP_LEN * HEAD_DIM, HEAD_DIM), (NSA_CMP_LEN * HEAD_DIM) ** -0.5),
        'nsa_cmp_w2': nrm(ks[9], (DEPTH, 2, HEAD_DIM, HEAD_DIM), 1.5 * HEAD_DIM ** -0.5),
        'nsa_cmp_pos': nrm(ks[10], (DEPTH, 2, NSA_CMP_LEN, HEAD_DIM), 0.1),
        'diff_lambda': nrm(ks[11], (DEPTH, 4, DIFF_QK_DIM), 0.1),
        'diff_subln_g': 1.0 + nrm(ks[12], (DEPTH, DIFF_V_DIM), 0.02),
        'w_out': nrm(ks[13], (DEPTH, MIX_WIDTH, D), MIX_WIDTH ** -0.5),
        'ffn_w_gate': nrm(ks[14], (DEPTH, D, D_FF), D ** -0.5),
        'ffn_w_up': nrm(ks[15], (DEPTH, D, D_FF), D ** -0.5),
        'ffn_w_down': nrm(ks[16], (DEPTH, D_FF, D), D_FF ** -0.5),
        'final_norm_g': 1.0 + nrm(ks[17], (D,), 0.02),
    }


def reference(x, c, ada_w, ada_b, norm_mix_g, norm_ffn_g, w_in, fox_f_bias, nsa_cmp_w1, nsa_cmp_w2,
              nsa_cmp_pos, diff_lambda, diff_subln_g, w_out, ffn_w_gate, ffn_w_up, ffn_w_down, final_norm_g):
    c_act = jax.nn.silu(c)
    h = x
    for layer in range(DEPTH):
        mod = c_act @ ada_w[layer] + ada_b[layer]
        sh1, sc1, g1, sh2, sc2, g2 = [m[:, None, :] for m in jnp.split(mod, 6, axis=-1)]
        lam_init = 0.8 - 0.6 * math.exp(-0.3 * layer)
        u = rms_norm(h, norm_mix_g[layer]) * (1.0 + sc1) + sh1
        h = h + g1 * hybrid_mixer(u, w_in[layer], fox_f_bias[layer], nsa_cmp_w1[layer], nsa_cmp_w2[layer],
                                  nsa_cmp_pos[layer], diff_lambda[layer], diff_subln_g[layer], lam_init, w_out[layer])
        u = rms_norm(h, norm_ffn_g[layer]) * (1.0 + sc2) + sh2
        h = h + g2 * swiglu(u, ffn_w_gate[layer], ffn_w_up[layer], ffn_w_down[layer])
    return rms_norm(h, final_norm_g)
```

```cpp
#include <hip/hip_runtime.h>
#include <cstdio>
#include <cstdint>
namespace pg8 {
#define PG8_LAS __attribute__((address_space(3)))
typedef unsigned short bf16_t;
typedef short bf16x8 __attribute__((ext_vector_type(8)));
typedef float f32x4 __attribute__((ext_vector_type(4)));
typedef unsigned u32x4 __attribute__((ext_vector_type(4)));
constexpr int BM = 256, BK = 64, HALF = 128, HTB = HALF * BK * 2  , STAGE_BYTES = 8 * HTB, NXCD = 8, WGM = 8;

__host__ __device__ __forceinline__ int lds_byte(int r, int c) { const int st = (r >> 4) * 2 + (c >> 5), rr = r & 15, cc = c & 31, ob = rr * 64 + cc * 2; return st * 1024 + (ob ^ (((ob >> 9) & 1) << 5)); }
__host__ __device__ __forceinline__ void stage_rc(int b, int& R, int& C) { const int st = b / 1024, sb = b % 1024, swz = sb ^ (((sb >> 9) & 1) << 5); R = (st >> 1) * 16 + swz / 64; C = (st & 1) * 32 + (swz % 64) / 2; }
__host__ __device__ __forceinline__ int perm32(int rho) { const int n = rho >> 4, i = rho & 15; return 8 * (i >> 2) + 4 * n + (i & 3); }

struct Unit { int pm, pn; };
struct Gemm { const bf16_t* A; const bf16_t* Bt; int M, N, K; };

struct StaticOrder {
    int nM, nN, nwg, G, c;
    __host__ __device__ void init(int M, int N, int G_, int c_) { nM = M / BM; nN = N / BM; nwg = nM * nN; G = G_; c = c_; }
    __host__ __device__ bool next(int i, Unit& u) const {
        const long L = (long)i * G + c; if (L >= nwg) return false;
        int wgid = (int)L; { const int q = nwg / NXCD, r = nwg % NXCD, xcd = wgid % NXCD, off = wgid / NXCD; wgid = (xcd < r ? xcd * (q + 1) : r * (q + 1) + (xcd - r) * q) + off; }
        const int nig = WGM * nN, gid = wgid / nig, fm = gid * WGM, gsz = (nM - fm) < WGM ? (nM - fm) : WGM;
        u.pm = fm + ((wgid % nig) % gsz); u.pn = (wgid % nig) / gsz; return true;
    }
    __device__ __forceinline__ void a_ready(const Unit&) const {}
    __device__ __forceinline__ void done(const Unit&) const {}
};
__device__ __forceinline__ unsigned cvt_pk_bf16(float lo, float hi) { unsigned r; asm volatile("v_cvt_pk_bf16_f32 %0, %1, %2" : "=v"(r) : "v"(lo), "v"(hi)); return r; }
struct EpiBf16 {
    static constexpr bool PERM = true, AFTER_DRAIN = false;
    bf16_t* O; int ldc;
    __device__ __forceinline__ void operator()(const f32x4 (&acc)[2][2][4][2], const Unit& u, int wr, int wc, int fr, int fq) const {
        const int row0 = u.pm * BM + wr * 64 + fr; const int col0 = u.pn * BM + wc * 32 + 8 * fq;
#pragma unroll
        for (int ai = 0; ai < 2; ++ai)
#pragma unroll
            for (int m = 0; m < 4; ++m) { bf16_t* rowp = O + (size_t)(row0 + ai * HALF + m * 16) * ldc + col0;
#pragma unroll
                for (int bj = 0; bj < 2; ++bj) { const f32x4 v0 = acc[ai][bj][m][0], v1 = acc[ai][bj][m][1];
                    u32x4 w; w.x = cvt_pk_bf16(v0[0], v0[1]); w.y = cvt_pk_bf16(v0[2], v0[3]); w.z = cvt_pk_bf16(v1[0], v1[1]); w.w = cvt_pk_bf16(v1[2], v1[3]);
                    *(u32x4*)(rowp + bj * HALF) = w; } }
    }
};
__device__ __forceinline__ float silu_mul(float g, float u) { return g / (1.0f + __expf(-g)) * u; }
struct EpiSwiglu {
    static constexpr bool PERM = true, AFTER_DRAIN = false;
    bf16_t* O; int ldc;
    __device__ __forceinline__ void operator()(const f32x4 (&acc)[2][2][4][2], const Unit& u, int wr, int wc, int fr, int fq) const {
        const int row0 = u.pm * BM + wr * 64 + fr; const int col0 = u.pn * HALF + wc * 32 + 8 * fq;
#pragma unroll
        for (int ai = 0; ai < 2; ++ai)
#pragma unroll
            for (int m = 0; m < 4; ++m) { bf16_t* rowp = O + (size_t)(row0 + ai * HALF + m * 16) * ldc + col0;
                const f32x4 g0 = acc[ai][0][m][0], g1 = acc[ai][0][m][1], u0 = acc[ai][1][m][0], u1 = acc[ai][1][m][1];
                u32x4 w; w.x = cvt_pk_bf16(silu_mul(g0[0], u0[0]), silu_mul(g0[1], u0[1])); w.y = cvt_pk_bf16(silu_mul(g0[2], u0[2]), silu_mul(g0[3], u0[3]));
                w.z = cvt_pk_bf16(silu_mul(g1[0], u1[0]), silu_mul(g1[1], u1[1])); w.w = cvt_pk_bf16(silu_mul(g1[2], u1[2]), silu_mul(g1[3], u1[3]));
                *(u32x4*)rowp = w; }
    }
};
struct EpiResid {
    static constexpr bool PERM = false, AFTER_DRAIN = false;
    const float* base; float* out; int ldc; const float* gate; int gstride;
    __device__ __forceinline__ void operator()(const f32x4 (&acc)[2][2][4][2], const Unit& u, int wr, int wc, int fr, int fq) const {
        const int col0 = u.pn * BM + wc * 32 + 4 * fq;
        const float* gp = gate + (size_t)((u.pm * BM) >> 12) * gstride + col0;
        f32x4 gv[2][2];
#pragma unroll
        for (int bj = 0; bj < 2; ++bj)
#pragma unroll
            for (int n = 0; n < 2; ++n) gv[bj][n] = *(const f32x4*)(gp + bj * HALF + n * 16);
#pragma unroll
        for (int ai = 0; ai < 2; ++ai)
#pragma unroll
            for (int m2 = 0; m2 < 2; ++m2) { f32x4 bs[2][2][2];
#pragma unroll
                for (int mm = 0; mm < 2; ++mm) { const size_t off = (size_t)(u.pm * BM + ai * HALF + wr * 64 + (2 * m2 + mm) * 16 + fr) * ldc + col0;
#pragma unroll
                    for (int bj = 0; bj < 2; ++bj)
#pragma unroll
                        for (int n = 0; n < 2; ++n) bs[mm][bj][n] = *(const f32x4*)(base + off + bj * HALF + n * 16); }
#pragma unroll
                for (int mm = 0; mm < 2; ++mm) { const size_t off = (size_t)(u.pm * BM + ai * HALF + wr * 64 + (2 * m2 + mm) * 16 + fr) * ldc + col0;
#pragma unroll
                    for (int bj = 0; bj < 2; ++bj)
#pragma unroll
                        for (int n = 0; n < 2; ++n) *(f32x4*)(out + off + bj * HALF + n * 16) = bs[mm][bj][n] + gv[bj][n] * acc[ai][bj][2 * m2 + mm][n]; }
                asm volatile("" ::: "memory"); }
    }
};

struct EpiResidB {
    static constexpr bool PERM = true, AFTER_DRAIN = false;
    const void* base; bf16_t* out; int ldc; const float* gate; int gstride; int base_f32;
    __device__ __forceinline__ void operator()(const f32x4 (&acc)[2][2][4][2], const Unit& u, int wr, int wc, int fr, int fq) const {
        const int row0 = u.pm * BM + wr * 64 + fr; const int col0 = u.pn * BM + wc * 32 + 8 * fq;
        const float* gp = gate + (size_t)((u.pm * BM) >> 12) * gstride + col0;
        f32x4 gv[2][2];
#pragma unroll
        for (int bj = 0; bj < 2; ++bj)
#pragma unroll
            for (int n = 0; n < 2; ++n) gv[bj][n] = *(const f32x4*)(gp + bj * HALF + n * 4);
        if (base_f32) { const float* bp = (const float*)base;
#pragma unroll
            for (int ai = 0; ai < 2; ++ai)
#pragma unroll
                for (int m2 = 0; m2 < 2; ++m2) { f32x4 bs[2][2][2];
#pragma unroll
                    for (int mm = 0; mm < 2; ++mm) { const size_t off = (size_t)(row0 + ai * HALF + (2 * m2 + mm) * 16) * ldc + col0;
#pragma unroll
                        for (int bj = 0; bj < 2; ++bj)
#pragma unroll
                            for (int n = 0; n < 2; ++n) bs[mm][bj][n] = *(const f32x4*)(bp + off + bj * HALF + n * 4); }
#pragma unroll
                    for (int mm = 0; mm < 2; ++mm) { const size_t off = (size_t)(row0 + ai * HALF + (2 * m2 + mm) * 16) * ldc + col0;
#pragma unroll
                        for (int bj = 0; bj < 2; ++bj) { const f32x4 v0 = bs[mm][bj][0] + gv[bj][0] * acc[ai][bj][2 * m2 + mm][0], v1 = bs[mm][bj][1] + gv[bj][1] * acc[ai][bj][2 * m2 + mm][1];
                            u32x4 w; w.x = cvt_pk_bf16(v0[0], v0[1]); w.y = cvt_pk_bf16(v0[2], v0[3]); w.z = cvt_pk_bf16(v1[0], v1[1]); w.w = cvt_pk_bf16(v1[2], v1[3]);
                            *(u32x4*)(out + off + bj * HALF) = w; } }
                    asm volatile("" ::: "memory"); }
        } else { const bf16_t* bp = (const bf16_t*)base;
#pragma unroll
            for (int ai = 0; ai < 2; ++ai) { u32x4 bs[4][2];
#pragma unroll
                for (int m = 0; m < 4; ++m) { const size_t off = (size_t)(row0 + ai * HALF + m * 16) * ldc + col0;
#pragma unroll
                    for (int bj = 0; bj < 2; ++bj) bs[m][bj] = *(const u32x4*)(bp + off + bj * HALF); }
#pragma unroll
                for (int m = 0; m < 4; ++m) { const size_t off = (size_t)(row0 + ai * HALF + m * 16) * ldc + col0;
#pragma unroll
                    for (int bj = 0; bj < 2; ++bj) { const u32x4 r = bs[m][bj]; const f32x4 a0 = acc[ai][bj][m][0], a1 = acc[ai][bj][m][1];
                        u32x4 w;
                        w.x = cvt_pk_bf16(__builtin_bit_cast(float, r.x << 16) + gv[bj][0][0] * a0[0], __builtin_bit_cast(float, r.x & 0xffff0000u) + gv[bj][0][1] * a0[1]);
                        w.y = cvt_pk_bf16(__builtin_bit_cast(float, r.y << 16) + gv[bj][0][2] * a0[2], __builtin_bit_cast(float, r.y & 0xffff0000u) + gv[bj][0][3] * a0[3]);
                        w.z = cvt_pk_bf16(__builtin_bit_cast(float, r.z << 16) + gv[bj][1][0] * a1[0], __builtin_bit_cast(float, r.z & 0xffff0000u) + gv[bj][1][1] * a1[1]);
                        w.w = cvt_pk_bf16(__builtin_bit_cast(float, r.w << 16) + gv[bj][1][2] * a1[2], __builtin_bit_cast(float, r.w & 0xffff0000u) + gv[bj][1][3] * a1[3]);
                        *(u32x4*)(out + off + bj * HALF) = w; } }
                asm volatile("" ::: "memory"); }
        }
    }
};
template <class Epi, class Sched, bool ALIGN_EPI = false, bool SP2 = false>
__device__ __forceinline__ void gemm_phase(PG8_LAS unsigned char* lds, const Gemm g, const Sched& S, const Epi& E) {
    int tid = threadIdx.x; asm volatile("" : "+v"(tid));
    const int wid = __builtin_amdgcn_readfirstlane(tid >> 6), lane = tid & 63, wr = wid >> 2, wc = wid & 3, fr = lane & 15, fq = lane >> 4;
    const int K = g.K, nt = K / BK;
    unsigned voffA[2], voffB[2];
#pragma unroll
    for (int i = 0; i < 2; ++i) { int R, C; stage_rc(tid * 16 + i * 8192, R, C); const int Rb = Epi::PERM ? ((R & ~31) + perm32(R & 31)) : R;
        voffA[i] = (unsigned)(R * K + C) * 2u; voffB[i] = (unsigned)(Rb * K + C) * 2u; }
    const size_t kstep = (size_t)(BK * 2);
    const size_t hstep = (size_t)HALF * K * 2;
    const size_t tstep = 2 * hstep;
    const unsigned ldsw = (unsigned)wid * 1024u;
    const int aoff = lds_byte(wr * 64 + fr, fq * 8), boff = lds_byte(wc * 32 + fr, fq * 8);
#define PG8_SA(b, h) (((b) * 2 + (h)) * HTB)
#define PG8_SB(b, h) ((4 + (b) * 2 + (h)) * HTB)
#define PG8_STAGE(bufoff, gbase, voff) do { _Pragma("unroll") for (int _i = 0; _i < 2; ++_i) \
        __builtin_amdgcn_global_load_lds((const unsigned*)((const char*)(gbase) + (voff)[_i]), (PG8_LAS unsigned*)(lds + (bufoff) + ldsw + _i * 8192), 16, 0, 0); } while (0)
#define PG8_LDA(dst, b, h) do { _Pragma("unroll") for (int m = 0; m < 4; ++m) _Pragma("unroll") for (int k = 0; k < 2; ++k) dst[m][k] = *(const PG8_LAS bf16x8*)(lds + PG8_SA(b, h) + aoff + m * 2048 + k * 1024); } while (0)
#define PG8_LDB(dst, b, h) do { _Pragma("unroll") for (int n = 0; n < 2; ++n) _Pragma("unroll") for (int k = 0; k < 2; ++k) dst[n][k] = *(const PG8_LAS bf16x8*)(lds + PG8_SB(b, h) + boff + n * 2048 + k * 1024); } while (0)
#define PG8_MMA(ai, bj, At, Bt) do { __builtin_amdgcn_s_setprio(1); _Pragma("unroll") for (int m = 0; m < 4; ++m) _Pragma("unroll") for (int n = 0; n < 2; ++n) _Pragma("unroll") for (int k = 0; k < 2; ++k) \
        acc[ai][bj][m][n] = __builtin_amdgcn_mfma_f32_16x16x32_bf16(Bt[n][k], At[m][k], acc[ai][bj][m][n], 0, 0, 0); __builtin_amdgcn_s_setprio(0); } while (0)
#define PG8_WAIT_V(n) asm volatile("s_waitcnt vmcnt(" #n ")" ::: "memory")
#define PG8_WAIT_L(n) asm volatile("s_waitcnt lgkmcnt(" #n ")" ::: "memory")
#define PG8_BAR __builtin_amdgcn_s_barrier()
#define PG8_SCHED __builtin_amdgcn_sched_barrier(0)
    Unit cur, nxt; int ui = 0;
    if (!S.next(0, cur)) return;
    f32x4 acc[2][2][4][2];
#pragma unroll
    for (int a = 0; a < 2; ++a)
#pragma unroll
        for (int b = 0; b < 2; ++b)
#pragma unroll
            for (int m = 0; m < 4; ++m)
#pragma unroll
                for (int n = 0; n < 2; ++n) acc[a][b][m][n] = (f32x4){0.f, 0.f, 0.f, 0.f};
    bf16x8 At[4][2], B0[2][2], B1[2][2];
    const char* cA = (const char*)g.A + (size_t)cur.pm * tstep; const char* cB = (const char*)g.Bt + (size_t)cur.pn * tstep;
    S.a_ready(cur);
    if constexpr (SP2) {
        PG8_STAGE(PG8_SB(0, 0), cB, voffB); PG8_STAGE(PG8_SB(0, 1), cB + hstep, voffB); PG8_STAGE(PG8_SA(0, 0), cA, voffA); PG8_STAGE(PG8_SA(0, 1), cA + hstep, voffA);
        if (wr == 1) PG8_BAR;
        PG8_WAIT_V(2); PG8_BAR;
        PG8_STAGE(PG8_SB(1, 0), cB + kstep, voffB); PG8_STAGE(PG8_SA(1, 0), cA + kstep, voffA); PG8_STAGE(PG8_SB(1, 1), cB + hstep + kstep, voffB);
        PG8_WAIT_V(6); PG8_BAR;
    } else {
        PG8_STAGE(PG8_SB(0, 0), cB, voffB); PG8_STAGE(PG8_SA(0, 0), cA, voffA); PG8_STAGE(PG8_SB(0, 1), cB + hstep, voffB); PG8_STAGE(PG8_SA(0, 1), cA + hstep, voffA);
        if (wr == 1) PG8_BAR;
        PG8_WAIT_V(4); PG8_BAR;
        PG8_STAGE(PG8_SB(1, 0), cB + kstep, voffB); PG8_STAGE(PG8_SA(1, 0), cA + kstep, voffA); PG8_STAGE(PG8_SB(1, 1), cB + hstep + kstep, voffB);
        PG8_WAIT_V(6); PG8_BAR;
    }
    for (;;) {
        const bool has_next = S.next(ui + 1, nxt);
        const char* nA = has_next ? (const char*)g.A + (size_t)nxt.pm * tstep : cA; const char* nB = has_next ? (const char*)g.Bt + (size_t)nxt.pn * tstep : cB;
        for (int t = 0; t < nt; t += 2) {
            const bool last = (t == nt - 2);
            const char* a1 = cA + (size_t)(t + 1) * kstep;
            const char* a2 = last ? nA : cA + (size_t)(t + 2) * kstep; const char* b2 = last ? nB : cB + (size_t)(t + 2) * kstep;
            const char* a3 = a2 + kstep; const char* b3 = b2 + kstep;
            if (last && has_next) S.a_ready(nxt);
            if constexpr (SP2) {
            PG8_LDB(B0, 0, 0); PG8_LDB(B1, 0, 1); PG8_SCHED; PG8_LDA(At, 0, 0); PG8_STAGE(PG8_SA(1, 1), a1 + hstep, voffA);
            PG8_WAIT_V(8); PG8_WAIT_L(0); PG8_BAR; PG8_MMA(0, 0, At, B0); PG8_MMA(0, 1, At, B1); PG8_BAR; PG8_SCHED;
            PG8_LDA(At, 0, 1); PG8_STAGE(PG8_SB(0, 0), b2, voffB); PG8_STAGE(PG8_SB(0, 1), b2 + hstep, voffB); PG8_STAGE(PG8_SA(0, 0), a2, voffA);
            PG8_WAIT_V(8); PG8_WAIT_L(0); PG8_BAR; PG8_MMA(1, 0, At, B0); PG8_MMA(1, 1, At, B1); PG8_BAR; PG8_SCHED;
            PG8_LDB(B0, 1, 0); PG8_LDB(B1, 1, 1); PG8_SCHED; PG8_LDA(At, 1, 0); PG8_STAGE(PG8_SA(0, 1), a2 + hstep, voffA);
            PG8_WAIT_V(8); PG8_WAIT_L(0); PG8_BAR; PG8_MMA(0, 0, At, B0); PG8_MMA(0, 1, At, B1); PG8_BAR; PG8_SCHED;
            PG8_LDA(At, 1, 1); PG8_STAGE(PG8_SB(1, 0), b3, voffB); PG8_STAGE(PG8_SB(1, 1), b3 + hstep, voffB); PG8_STAGE(PG8_SA(1, 0), a3, voffA);
            PG8_WAIT_V(8); PG8_WAIT_L(0); PG8_BAR; PG8_MMA(1, 0, At, B0); PG8_MMA(1, 1, At, B1); PG8_BAR; PG8_SCHED;
            } else {
            PG8_LDB(B0, 0, 0); PG8_SCHED; PG8_LDA(At, 0, 0); PG8_STAGE(PG8_SA(1, 1), a1 + hstep, voffA);
            PG8_WAIT_L(8); PG8_BAR; PG8_WAIT_L(0); PG8_MMA(0, 0, At, B0); PG8_BAR; PG8_SCHED;
            PG8_LDB(B1, 0, 1); PG8_STAGE(PG8_SB(0, 0), b2, voffB);
            PG8_BAR; PG8_WAIT_L(0); PG8_MMA(0, 1, At, B1); PG8_BAR;
            PG8_LDA(At, 0, 1); PG8_STAGE(PG8_SA(0, 0), a2, voffA);
            PG8_BAR; PG8_WAIT_L(0); PG8_MMA(1, 0, At, B0); PG8_BAR; PG8_SCHED;
            PG8_STAGE(PG8_SB(0, 1), b2 + hstep, voffB);
            PG8_WAIT_V(6); PG8_BAR; PG8_MMA(1, 1, At, B1); PG8_BAR;
            PG8_LDB(B0, 1, 0); PG8_SCHED; PG8_LDA(At, 1, 0); PG8_STAGE(PG8_SA(0, 1), a2 + hstep, voffA);
            PG8_WAIT_L(8); PG8_BAR; PG8_WAIT_L(0); PG8_MMA(0, 0, At, B0); PG8_BAR; PG8_SCHED;
            PG8_LDB(B1, 1, 1); PG8_STAGE(PG8_SB(1, 0), b3, voffB);
            PG8_BAR; PG8_WAIT_L(0); PG8_MMA(0, 1, At, B1); PG8_BAR;
            PG8_LDA(At, 1, 1); PG8_STAGE(PG8_SA(1, 0), a3, voffA);
            PG8_BAR; PG8_WAIT_L(0); PG8_MMA(1, 0, At, B0); PG8_BAR; PG8_SCHED;
            PG8_STAGE(PG8_SB(1, 1), b3 + hstep, voffB);
            PG8_WAIT_V(6); PG8_BAR; PG8_MMA(1, 1, At, B1); PG8_BAR;
            }
        }
        if constexpr (ALIGN_EPI) { if (wr == 0) PG8_BAR; }
        if constexpr (!Epi::AFTER_DRAIN) { E(acc, cur, wr, wc, fr, fq); S.done(cur); }
        if (!has_next) break;
#pragma unroll
        for (int a = 0; a < 2; ++a)
#pragma unroll
            for (int b = 0; b < 2; ++b)
#pragma unroll
                for (int m = 0; m < 4; ++m)
#pragma unroll
                    for (int n = 0; n < 2; ++n) acc[a][b][m][n] = (f32x4){0.f, 0.f, 0.f, 0.f};
        cur = nxt; cA = nA; cB = nB; ++ui;
        if constexpr (ALIGN_EPI) { if (wr == 1) PG8_BAR; }
    }
    PG8_WAIT_V(0);
    if constexpr (!ALIGN_EPI) { if (wr == 0) PG8_BAR; }
    PG8_BAR;
    if constexpr (Epi::AFTER_DRAIN) { E.fused(acc, cur, wr, wc, fr, fq, lds, wid, lane); S.done(cur); }
#undef PG8_SA
#undef PG8_SB
#undef PG8_STAGE
#undef PG8_LDA
#undef PG8_LDB
#undef PG8_MMA
#undef PG8_WAIT_V
#undef PG8_WAIT_L
#undef PG8_BAR
#undef PG8_SCHED
}
}

constexpr int BATCH = 2, SEQ = 4096, DM = 2048, DEPTH = 4, M = BATCH * SEQ;
constexpr int NIN = 5919, NINP = 6144, DFF = 5632, NGU = 2 * DFF, NADA = 6 * DM;
constexpr int C_FOXQ = 0, C_FOXK = 448, C_FOXV = 896, C_NSAQ = 1344, C_CMPK = 1856, C_CMPV = 1984, C_SLCK = 2112, C_SLCV = 2240, C_WINK = 2368, C_WINV = 2496,
              C_DILQ = 2624, C_DILK = 3200, C_DILV = 3776, C_DIFQ = 4352, C_DIFK = 4864, C_DIFV = 5376, C_FOXF = 5888, C_GATE = 5896;
constexpr int O_FOX = 0, O_NSA = 448, O_DIL = 960, O_DIF = 1536;
constexpr size_t MiB = 1u << 20;
constexpr size_t WS_CTL = 0, CTL_ZERO_BYTES = 1 * MiB;
constexpr size_t WS_MOD = 1 * MiB;
constexpr size_t WS_CUM = 2 * MiB;
constexpr size_t WS_KC = 3 * MiB;
constexpr size_t WS_VCB = 3 * MiB + 512 * 1024;
constexpr size_t WS_SEL = 4 * MiB;
constexpr size_t WS_W1T = 5 * MiB;
constexpr size_t WS_W2T = 7 * MiB;
constexpr size_t WS_PW1 = 7 * MiB + 64 * 1024;
constexpr size_t WS_U = 8 * MiB;
constexpr size_t WS_O = 40 * MiB;
constexpr size_t WS_H = 72 * MiB;
constexpr size_t WS_PROJ = 136 * MiB;
constexpr size_t WS_ACT = 232 * MiB;
constexpr size_t WS_W = 320 * MiB;
constexpr size_t W_IN = 0, W_OUT = 24 * MiB, W_GU = 32 * MiB, W_D = 76 * MiB, W_LAYER = 98 * MiB;
constexpr size_t WS_VTB = WS_W + DEPTH * W_LAYER;
constexpr size_t WS_STASH = WS_VTB + 28 * MiB;
constexpr size_t WS_END = WS_STASH + 64 * MiB;
static_assert((size_t)NINP * DM * 2 == 24 * MiB && (size_t)NGU * DM * 2 == 44 * MiB && (size_t)DM * DFF * 2 == 22 * MiB, "weight copy sizes");
constexpr int CW_BAR = 4096;
constexpr int CW_WQ = 16384;
constexpr int RING_BYTES = 131072, LDSCTL_OFF = RING_BYTES, MISC_OFF = LDSCTL_OFF + 320, LDS_BYTES = 147456;
constexpr int NWAVES = 8;
constexpr int NPL = 9, NPH = 2 + DEPTH * NPL;
#ifndef N_LAUNCH_MODE
#define N_LAUNCH_MODE 0
#endif

#define GAS __attribute__((address_space(1)))
#define LAS __attribute__((address_space(3)))
typedef unsigned short bf16;
typedef unsigned v4u __attribute__((ext_vector_type(4)));
typedef unsigned v2u __attribute__((ext_vector_type(2)));
typedef float f32x4 __attribute__((ext_vector_type(4)));
typedef GAS unsigned gu32;
#define RLX_AGENT __ATOMIC_RELAXED, __HIP_MEMORY_SCOPE_AGENT
#define LDS_WAIT() asm volatile("s_waitcnt lgkmcnt(0)" ::: "memory")
#define VM_WAIT() asm volatile("s_waitcnt vmcnt(0)" ::: "memory")
__device__ __forceinline__ unsigned f2bf(float f) { unsigned u = __builtin_bit_cast(unsigned, f); return (u + 0x7fffu + ((u >> 16) & 1u)) >> 16; }
__device__ __forceinline__ unsigned pk2(float lo, float hi) { return f2bf(lo) | (f2bf(hi) << 16); }
__device__ __forceinline__ float bf2f(bf16 x) { return __builtin_bit_cast(float, (unsigned)x << 16); }
__device__ __forceinline__ float lo16(unsigned w) { return __builtin_bit_cast(float, w << 16); }
__device__ __forceinline__ float hi16(unsigned w) { return __builtin_bit_cast(float, w & 0xffff0000u); }
template <int K> __device__ __forceinline__ int lx_i(int v) { static_assert(K >= 1 && K < 32, ""); return __builtin_amdgcn_ds_swizzle(v, (K << 10) | 0x1f); }
template <int K> __device__ __forceinline__ float lx(float v) { return __builtin_bit_cast(float, lx_i<K>(__builtin_bit_cast(int, v))); }
__device__ __forceinline__ void half_swap(unsigned u, unsigned& a, unsigned& b) { unsigned u2 = u; asm volatile("" : "+v"(u2)); const auto r = __builtin_amdgcn_permlane32_swap(u, u2, false, false); a = r[0]; b = r[1]; }
__device__ __forceinline__ float half_sum(float v) { unsigned a, b; half_swap(__builtin_bit_cast(unsigned, v), a, b); return __builtin_bit_cast(float, a) + __builtin_bit_cast(float, b); }
__device__ __forceinline__ float half_max(float v) { unsigned a, b; half_swap(__builtin_bit_cast(unsigned, v), a, b); return fmaxf(__builtin_bit_cast(float, a), __builtin_bit_cast(float, b)); }
__device__ __forceinline__ unsigned half_or(unsigned u) { unsigned a, b; half_swap(u, a, b); return a | b; }
__device__ __forceinline__ float half_other(float v, int hh  ) { unsigned a, b; half_swap(__builtin_bit_cast(unsigned, v), a, b); return __builtin_bit_cast(float, hh ? a : b); }

#define XB_TMO      128
#define XB_XCNT(j)  (256  + 64 * (j))
#define XB_XSUB(j)  (1280 + 64 * (j))
#define XB_XGEN(j)  (2304 + 64 * (j))
#define XB_TOP      3328
#define XB_TOPGEN   3392
#define XCD_BAR_WORDS 3456
#define XB_SPIN_CAP (1u << 18)

__device__ __forceinline__ unsigned xb_ld(unsigned* p)              { return __hip_atomic_load(p, __ATOMIC_RELAXED, __HIP_MEMORY_SCOPE_AGENT); }
__device__ __forceinline__ unsigned xb_add(unsigned* p, unsigned v) { return __hip_atomic_fetch_add(p, v, __ATOMIC_RELAXED, __HIP_MEMORY_SCOPE_AGENT); }
__device__ __forceinline__ unsigned xb_xcc_id() { return (unsigned)__builtin_amdgcn_s_getreg((3 << 11) | 20) & 0xFu; }
#define XB_SPIN(cond, bar) do { unsigned _sp = 0; while (cond) { __builtin_amdgcn_s_sleep(1); \
    if ((++_sp & 255u) == 0u) { if (xb_ld(&(bar)[XB_TMO])) break; if (_sp > XB_SPIN_CAP) { atomicAdd(&(bar)[XB_TMO], 1u); break; } } } } while (0)

struct XcdBarrier {
    unsigned* bar; unsigned x;
    volatile LAS unsigned* st;
};

__device__ __forceinline__ XcdBarrier xcd_barrier_post(unsigned* bar, volatile LAS unsigned* st) {
    XcdBarrier b; b.bar = bar; b.x = xb_xcc_id(); b.st = st;
    if (threadIdx.x == 0) (void)xb_add(&bar[XB_XCNT(b.x)], 1u);
    return b;
}
__device__ __forceinline__ void xcd_barrier_complete(unsigned* bar, unsigned x, unsigned& nloc, unsigned& nx) {
    const unsigned G = gridDim.x * gridDim.y * gridDim.z;
    unsigned sum, cnt, mine, sp = 0u;
    for (;;) {
        sum = 0u; cnt = 0u; mine = 0u;
#pragma unroll
        for (unsigned j = 0; j < 16; ++j) { const unsigned c = xb_ld(&bar[XB_XCNT(j)]); sum += c; cnt += (c > 0u) ? 1u : 0u; mine = (j == x) ? c : mine; }
        if (sum == G) break;
        __builtin_amdgcn_s_sleep(1);
        if ((++sp & 255u) == 0u) { if (xb_ld(&bar[XB_TMO])) break; if (sp > XB_SPIN_CAP) { atomicAdd(&bar[XB_TMO], 1u); break; } }
    }
    nloc = mine > 0u ? mine : 1u; nx = cnt > 0u ? cnt : 1u;
}

__device__ __forceinline__ void xcd_barrier(const XcdBarrier& b) {
    asm volatile("s_waitcnt vmcnt(0)" ::: "memory");
    __syncthreads();
    if (threadIdx.x == 0) {
        unsigned* bar = b.bar;
        __builtin_amdgcn_s_waitcnt(0);
        unsigned nloc = b.st[0], nx = b.st[1];
        if (nloc == 0u) { xcd_barrier_complete(bar, b.x, nloc, nx); b.st[0] = nloc; b.st[1] = nx; }
        const unsigned old = xb_add(&bar[XB_XSUB(b.x)], 1u);
        const unsigned gen = old / nloc;
        if (old + 1u == (gen + 1u) * nloc) {
            __builtin_amdgcn_fence(__ATOMIC_RELEASE, "agent");
            asm volatile("s_waitcnt vmcnt(0)" ::: "memory");
            const unsigned og = xb_add(&bar[XB_TOP], 1u);
            const unsigned tg = og / nx;
            if (og + 1u == (tg + 1u) * nx) xb_add(&bar[XB_TOPGEN], 1u);
            else XB_SPIN(xb_ld(&bar[XB_TOPGEN]) == tg, bar);
            __builtin_amdgcn_fence(__ATOMIC_ACQUIRE, "agent");
            xb_add(&bar[XB_XGEN(b.x)], 1u);
            asm volatile("s_waitcnt vmcnt(0)" ::: "memory");
        } else {
            XB_SPIN(xb_ld(&bar[XB_XGEN(b.x)]) == gen, bar);
            __builtin_amdgcn_fence(__ATOMIC_ACQUIRE, "agent");
            asm volatile("s_waitcnt vmcnt(0)" ::: "memory");
        }
    }
    __syncthreads();
}

__device__ __forceinline__ float wave_sum(float v) { v += lx<1>(v); v += lx<2>(v); v += lx<4>(v); v += lx<8>(v); v += lx<16>(v); return half_sum(v); }
__device__ __forceinline__ float wave_max(float v) { v = fmaxf(v, lx<1>(v)); v = fmaxf(v, lx<2>(v)); v = fmaxf(v, lx<4>(v)); v = fmaxf(v, lx<8>(v)); v = fmaxf(v, lx<16>(v)); return half_max(v); }
__device__ __forceinline__ void load_row64(const bf16* p, float (&q)[64]) {
#pragma unroll
    for (int c = 0; c < 8; ++c) { const v4u w = ((const v4u*)p)[c];
        q[8 * c + 0] = lo16(w.x); q[8 * c + 1] = hi16(w.x); q[8 * c + 2] = lo16(w.y); q[8 * c + 3] = hi16(w.y);
        q[8 * c + 4] = lo16(w.z); q[8 * c + 5] = hi16(w.z); q[8 * c + 6] = lo16(w.w); q[8 * c + 7] = hi16(w.w); }
}
__device__ __forceinline__ float dot64(const float (&q)[64], const bf16* p) {
    float a0 = 0.f, a1 = 0.f, a2 = 0.f, a3 = 0.f;
#pragma unroll
    for (int c = 0; c < 8; ++c) { const v4u w = ((const v4u*)p)[c];
        a0 = fmaf(q[8 * c + 0], lo16(w.x), a0); a1 = fmaf(q[8 * c + 1], hi16(w.x), a1); a2 = fmaf(q[8 * c + 2], lo16(w.y), a2); a3 = fmaf(q[8 * c + 3], hi16(w.y), a3);
        a0 = fmaf(q[8 * c + 4], lo16(w.z), a0); a1 = fmaf(q[8 * c + 5], hi16(w.z), a1); a2 = fmaf(q[8 * c + 6], lo16(w.w), a2); a3 = fmaf(q[8 * c + 7], hi16(w.w), a3);
        if ((c & 3) == 3) asm volatile("" ::: "memory"); }
    return (a0 + a1) + (a2 + a3);
}
template <int N8> __device__ __forceinline__ void att_update(float sc, bool valid, const bf16* vrow, float& m, float& l, float (&o)[8 * N8]) {
    if (valid) {
        if (sc > m) { const float corr = __expf(m - sc); l *= corr;
#pragma unroll
            for (int d = 0; d < 8 * N8; ++d) o[d] *= corr;
            m = sc; }
        const float p = __expf(sc - m); l += p;
#pragma unroll
        for (int c = 0; c < N8; ++c) { const v4u w = ((const v4u*)vrow)[c];
            o[8 * c + 0] = fmaf(p, lo16(w.x), o[8 * c + 0]); o[8 * c + 1] = fmaf(p, hi16(w.x), o[8 * c + 1]); o[8 * c + 2] = fmaf(p, lo16(w.y), o[8 * c + 2]); o[8 * c + 3] = fmaf(p, hi16(w.y), o[8 * c + 3]);
            o[8 * c + 4] = fmaf(p, lo16(w.z), o[8 * c + 4]); o[8 * c + 5] = fmaf(p, hi16(w.z), o[8 * c + 5]); o[8 * c + 6] = fmaf(p, lo16(w.w), o[8 * c + 6]); o[8 * c + 7] = fmaf(p, hi16(w.w), o[8 * c + 7]);
            if ((c & 3) == 3) asm volatile("" ::: "memory"); }
    }
}
template <int N8> __device__ __forceinline__ void store_row(bf16* p, const float (&o)[8 * N8], float s) {
#pragma unroll
    for (int c = 0; c < N8; ++c) { v4u w; w.x = pk2(o[8 * c + 0] * s, o[8 * c + 1] * s); w.y = pk2(o[8 * c + 2] * s, o[8 * c + 3] * s); w.z = pk2(o[8 * c + 4] * s, o[8 * c + 5] * s); w.w = pk2(o[8 * c + 6] * s, o[8 * c + 7] * s);
        ((v4u*)p)[c] = w; }
}
__device__ __forceinline__ float log_sigmoid(float x) { return fminf(x, 0.f) - log1pf(__expf(-fabsf(x))); }
__device__ __forceinline__ float sigmoidf_(float x) { return 1.f / (1.f + __expf(-x)); }
__device__ __forceinline__ float gelu_tanh(float x) { const float u = 0.7978845608028654f * (x + 0.044715f * x * x * x); return 0.5f * x * (1.f + tanhf(u)); }

__device__ __forceinline__ void tr_item(const float* W, int K, int N, int srccol, bf16* WT, int destrow0, int k0, LAS float* scr, int lane) {
#pragma unroll 8
    for (int i = 0; i < 32; ++i) { const int kk = 2 * i + (lane >> 5); scr[kk * 33 + (lane & 31)] = srccol >= 0 ? W[(size_t)(k0 + kk) * N + srccol] : 0.f; }
    LDS_WAIT(); asm volatile("" ::: "memory");
    const int c = lane & 7;
#pragma unroll
    for (int j = 0; j < 4; ++j) { const int n = (lane >> 3) + 8 * j; const LAS float* s = scr + (8 * c) * 33 + n;
        v4u o; o.x = pk2(s[0 * 33], s[1 * 33]); o.y = pk2(s[2 * 33], s[3 * 33]); o.z = pk2(s[4 * 33], s[5 * 33]); o.w = pk2(s[6 * 33], s[7 * 33]);
        *(v4u*)(WT + (size_t)(destrow0 + n) * K + k0 + 8 * c) = o; }
    LDS_WAIT(); asm volatile("" ::: "memory");
}
__device__ __forceinline__ int src_col_in(int n) {
    if (n < 1344) return n;
    if (n < 2624) return n + 7;
    if (n < 5888) return n + 31;
    if (n < 5895) return n - 5888 + 1344;
    if (n >= 5896 && n < 5920) return n - 5896 + 2631;
    return -1;
}
__device__ __forceinline__ void tr64_item(const float* W, int K, int N, int srccol, bf16* WT, int destrow0  , int k0, LAS unsigned char* scr, int lane) {
    const float* src = W + (size_t)k0 * N + (srccol >= 0 ? srccol : 0);
#pragma unroll
    for (int h = 0; h < 2; ++h) { float v[32];
#pragma unroll
        for (int i = 0; i < 32; ++i) v[i] = srccol >= 0 ? src[(size_t)(32 * h + i) * N] : 0.f;
#pragma unroll
        for (int c = 0; c < 4; ++c) { v4u o; o.x = pk2(v[8 * c], v[8 * c + 1]); o.y = pk2(v[8 * c + 2], v[8 * c + 3]); o.z = pk2(v[8 * c + 4], v[8 * c + 5]); o.w = pk2(v[8 * c + 6], v[8 * c + 7]);
            *(LAS v4u*)(scr + lane * 128 + (((4 * h + c) ^ (lane & 7)) << 4)) = o; } }
    LDS_WAIT(); asm volatile("" ::: "memory");
    const int r = lane >> 3, c = lane & 7;
#pragma unroll
    for (int j = 0; j < 8; ++j) { const int n = r + 8 * j; const v4u o = *(const LAS v4u*)(scr + n * 128 + ((c ^ (n & 7)) << 4));
        *(v4u*)(WT + (size_t)(destrow0 + n) * K + k0 + 8 * c) = o; }
    LDS_WAIT(); asm volatile("" ::: "memory");
}
constexpr int I_IN = (DM / 64) * (NINP / 64), I_OUT = (DM / 64) * (DM / 64), I_GU = (DM / 64) * (NGU / 64), I_D = (DFF / 64) * (DM / 64), I_LAYER = I_IN + I_OUT + I_GU + I_D;
__device__ __forceinline__ void conv_item(const float* w_in, const float* w_out, const float* w_gate, const float* w_up, const float* w_down, unsigned char* ws, int layer, int r, LAS unsigned char* scr, int lane) {
    {
        unsigned char* wl = ws + WS_W + (size_t)layer * W_LAYER;
        if (r < I_IN) { const int nblk = NINP / 64, kb = r / nblk, nb = r % nblk;
            tr64_item(w_in + (size_t)layer * DM * NIN, DM, NIN, src_col_in(nb * 64 + lane), (bf16*)(wl + W_IN), nb * 64, kb * 64, scr, lane); return; }
        r -= I_IN;
        if (r < I_OUT) { const int nblk = DM / 64, kb = r / nblk, nb = r % nblk;
            tr64_item(w_out + (size_t)layer * DM * DM, DM, DM, nb * 64 + lane, (bf16*)(wl + W_OUT), nb * 64, kb * 64, scr, lane); return; }
        r -= I_OUT;
        if (r < I_GU) { const int nblk = NGU / 64, kb = r / nblk, nb = r % nblk, n0 = nb * 64, pn = n0 >> 8, w0 = n0 & 255;
            const float* W = (w0 < 128 ? w_gate : w_up) + (size_t)layer * DM * DFF;
            tr64_item(W, DM, DFF, pn * 128 + (w0 & 127) + lane, (bf16*)(wl + W_GU), n0, kb * 64, scr, lane); return; }
        r -= I_GU;
        { const int nblk = DM / 64, kb = r / nblk, nb = r % nblk;
            tr64_item(w_down + (size_t)layer * DFF * DM, DFF, DM, nb * 64 + lane, (bf16*)(wl + W_D), nb * 64, kb * 64, scr, lane); }
    }
}
__device__ __forceinline__ void p0_weights(const float* w_in, const float* w_out, const float* w_gate, const float* w_up, const float* w_down, unsigned char* ws, LAS unsigned char* scr, int gw, int NGW, int lane) {
    for (int it = gw; it < I_LAYER; it += NGW) conv_item(w_in, w_out, w_gate, w_up, w_down, ws, 0, it, scr, lane);
}
__device__ __forceinline__ void p0_mod(const float* c, const float* ada_w, const float* ada_b, float* MOD, LAS unsigned char* lds, int bid, int G, int tid, int wave, int lane) {
    LAS float* cact = (LAS float*)lds;
    LAS f32x4* red = (LAS f32x4*)(lds + 16384);
    for (int i = tid; i < BATCH * DM; i += NWAVES * 64) { const float x = c[i]; cact[i] = x / (1.f + __expf(-x)); }
    __syncthreads();
    for (int it = bid; it < DEPTH * (NADA / 192); it += G) {
        const int layer = it / (NADA / 192), cg = it % (NADA / 192);
        f32x4 a0 = {0.f, 0.f, 0.f, 0.f}, a1 = {0.f, 0.f, 0.f, 0.f};
        if (lane < 48) { const float* wp = ada_w + (size_t)layer * DM * NADA + cg * 192 + lane * 4;
#pragma unroll 16
            for (int k = wave * 256; k < wave * 256 + 256; ++k) { const f32x4 w = *(const f32x4*)(wp + (size_t)k * NADA); a0 += cact[k] * w; a1 += cact[DM + k] * w; }
            red[(wave * 2 + 0) * 48 + lane] = a0; red[(wave * 2 + 1) * 48 + lane] = a1; }
        __syncthreads();
        if (tid < 2 * 192) { const int b = tid / 192, cc = tid % 192; float s = 0.f;
#pragma unroll
            for (int w = 0; w < 8; ++w) s += ((LAS float*)red)[((w * 2 + b) * 48 + (cc >> 2)) * 4 + (cc & 3)];
            MOD[(size_t)(layer * BATCH + b) * NADA + cg * 192 + cc] = s + ada_b[(size_t)layer * NADA + cg * 192 + cc]; }
        __syncthreads();
    }
}
__device__ __forceinline__ void p0_cmpw(const float* w1, const float* w2, const float* pos, unsigned char* ws, LAS unsigned char* lds, int gw, int NGW, int bid, int G, int wave, int lane) {
    LAS float* scr = (LAS float*)(lds + wave * 16384);
    for (int it = gw; it < DEPTH * 2 * 64 + DEPTH * 2 * 2; it += NGW) {
        if (it < DEPTH * 2 * 64) { const int lk = it >> 6, r = it & 63, kb = r >> 1, nb = r & 1;
            tr_item(w1 + (size_t)lk * 2048 * 64, 2048, 64, nb * 32 + (lane & 31), (bf16*)(ws + WS_W1T) + (size_t)lk * 64 * 2048, nb * 32, kb * 64, scr, lane); }
        else { const int r = it - DEPTH * 2 * 64, lk = r >> 1, nb = r & 1;
            tr_item(w2 + (size_t)lk * 64 * 64, 64, 64, nb * 32 + (lane & 31), (bf16*)(ws + WS_W2T) + (size_t)lk * 64 * 64, nb * 32, 0, scr, lane); }
    }
    __syncthreads();
    LAS float* red = (LAS float*)(lds + 12288);
    for (int it = bid; it < DEPTH * 2; it += G) {
        const float* W = w1 + (size_t)it * 2048 * 64 + lane; const float* P = pos + (size_t)it * 2048; float a = 0.f;
#pragma unroll 8
        for (int k = wave * 256; k < wave * 256 + 256; ++k) a = fmaf(P[k], W[(size_t)k * 64], a);
        red[wave * 64 + lane] = a;
        __syncthreads();
        if (wave == 0) { float s = 0.f;
#pragma unroll
            for (int w = 0; w < 8; ++w) s += red[w * 64 + lane];
            ((float*)(ws + WS_PW1))[it * 64 + lane] = s; }
        __syncthreads();
    }
}
__device__ __forceinline__ void norm_mod_rows(const float* src, const float* gain, const float* sh, const float* sc, bf16* dst, int gw, int NGW, int lane) {
    f32x4 cur[8], nxt[8], A[8], B[8]; int cb = -1;
    if (gw < M) { const GAS f32x4* xr = (const GAS f32x4*)(src + (size_t)gw * DM) + lane;
#pragma unroll
        for (int j = 0; j < 8; ++j) cur[j] = xr[64 * j]; }
#pragma unroll 1
    for (int m = gw; m < M; m += NGW) { const int b = m >> 12; const int mn = m + NGW < M ? m + NGW : m;
        { const GAS f32x4* xr = (const GAS f32x4*)(src + (size_t)mn * DM) + lane;
#pragma unroll
            for (int j = 0; j < 8; ++j) nxt[j] = xr[64 * j]; }
        if (b != cb) { cb = b;
#pragma unroll
            for (int j = 0; j < 8; ++j) { const int col = 4 * (64 * j + lane);
                const f32x4 g4 = *(const GAS f32x4*)(gain + col), s4 = *(const GAS f32x4*)(sc + (size_t)b * NADA + col); A[j] = g4 * (1.f + s4); B[j] = *(const GAS f32x4*)(sh + (size_t)b * NADA + col); } }
        __builtin_amdgcn_sched_barrier(0);
        float ss = 0.f;
#pragma unroll
        for (int j = 0; j < 8; ++j) ss += (cur[j].x * cur[j].x + cur[j].y * cur[j].y) + (cur[j].z * cur[j].z + cur[j].w * cur[j].w);
        const float rstd = rsqrtf(wave_sum(ss) * (1.f / DM) + 1e-6f);
        v2u* o8 = (v2u*)(dst + (size_t)m * DM) + lane;
#pragma unroll
        for (int j = 0; j < 8; ++j) { const f32x4 y = cur[j] * rstd * A[j] + B[j]; v2u w; w.x = pk2(y.x, y.y); w.y = pk2(y.z, y.w); o8[64 * j] = w; }
#pragma unroll
        for (int j = 0; j < 8; ++j) cur[j] = nxt[j];
    }
}
__device__ __forceinline__ void norm_mod_rows_b(const bf16* src, const float* gain, const float* sh, const float* sc, bf16* dst, int gw, int NGW, int lane) {
    v4u cur[4], nxt[4]; f32x4 A[8], B[8]; int cb = -1;
    if (gw < M) { const GAS v4u* xr = (const GAS v4u*)(src + (size_t)gw * DM) + lane;
#pragma unroll
        for (int j = 0; j < 4; ++j) cur[j] = xr[64 * j]; }
#pragma unroll 1
    for (int m = gw; m < M; m += NGW) { const int b = m >> 12; const int mn = m + NGW < M ? m + NGW : m;
        { const GAS v4u* xr = (const GAS v4u*)(src + (size_t)mn * DM) + lane;
#pragma unroll
            for (int j = 0; j < 4; ++j) nxt[j] = xr[64 * j]; }
        if (b != cb) { cb = b;
#pragma unroll
            for (int j = 0; j < 4; ++j)
#pragma unroll
                for (int h = 0; h < 2; ++h) { const int col = 8 * (64 * j + lane) + 4 * h;
                    const f32x4 g4 = *(const GAS f32x4*)(gain + col), s4 = *(const GAS f32x4*)(sc + (size_t)b * NADA + col); A[2 * j + h] = g4 * (1.f + s4); B[2 * j + h] = *(const GAS f32x4*)(sh + (size_t)b * NADA + col); } }
        __builtin_amdgcn_sched_barrier(0);
        f32x4 x[8];
#pragma unroll
        for (int j = 0; j < 4; ++j) { x[2 * j] = (f32x4){lo16(cur[j].x), hi16(cur[j].x), lo16(cur[j].y), hi16(cur[j].y)}; x[2 * j + 1] = (f32x4){lo16(cur[j].z), hi16(cur[j].z), lo16(cur[j].w), hi16(cur[j].w)}; }
        float ss = 0.f;
#pragma unroll
        for (int j = 0; j < 8; ++j) ss += (x[j].x * x[j].x + x[j].y * x[j].y) + (x[j].z * x[j].z + x[j].w * x[j].w);
        const float rstd = rsqrtf(wave_sum(ss) * (1.f / DM) + 1e-6f);
        v4u* o16 = (v4u*)(dst + (size_t)m * DM) + lane;
#pragma unroll
        for (int j = 0; j < 4; ++j) { const f32x4 y0 = x[2 * j] * rstd * A[2 * j] + B[2 * j], y1 = x[2 * j + 1] * rstd * A[2 * j + 1] + B[2 * j + 1];
            v4u w; w.x = pk2(y0.x, y0.y); w.y = pk2(y0.z, y0.w); w.z = pk2(y1.x, y1.y); w.w = pk2(y1.z, y1.w); o16[64 * j] = w; }
#pragma unroll
        for (int j = 0; j < 4; ++j) cur[j] = nxt[j];
    }
}
__device__ __forceinline__ void norm_final_rows(const bf16* src, const float* gain, float* dst, int gw, int NGW, int lane) {
    for (int m = gw; m < M; m += NGW) {
        const v4u* xr = (const v4u*)(src + (size_t)m * DM) + lane; f32x4 v[8]; float ss = 0.f;
#pragma unroll
        for (int j = 0; j < 4; ++j) { const v4u c = xr[64 * j]; v[2 * j] = (f32x4){lo16(c.x), hi16(c.x), lo16(c.y), hi16(c.y)}; v[2 * j + 1] = (f32x4){lo16(c.z), hi16(c.z), lo16(c.w), hi16(c.w)}; }
#pragma unroll
        for (int j = 0; j < 8; ++j) ss += (v[j].x * v[j].x + v[j].y * v[j].y) + (v[j].z * v[j].z + v[j].w * v[j].w);
        const float rstd = rsqrtf(wave_sum(ss) * (1.f / DM) + 1e-6f);
        float* o = dst + (size_t)m * DM;
#pragma unroll
        for (int j = 0; j < 4; ++j)
#pragma unroll
            for (int h = 0; h < 2; ++h) { const int col = 8 * (64 * j + lane) + 4 * h; const f32x4 g4 = *(const f32x4*)(gain + col); *(f32x4*)(o + col) = v[2 * j + h] * rstd * g4; }
    }
}
__device__ __forceinline__ void fox_cum_block(const bf16* PROJ, const float* fbias, float* CUM, int ci, LAS unsigned char* lds, int wave, int lane) {
    const int b = ci / 7, h = ci % 7; const float bias = fbias[h];
    const bf16* fp = PROJ + ((size_t)b * SEQ + 512 * wave + lane) * NINP + C_FOXF + h; float* cp = CUM + (size_t)(b * 7 + h) * SEQ + 512 * wave + lane;
    float x[8], vals[8]; float carry = 0.f;
#pragma unroll
    for (int u = 0; u < 8; ++u) x[u] = bf2f(fp[(size_t)(64 * u) * NINP]);
#pragma unroll
    for (int u = 0; u < 8; ++u) { float v = log_sigmoid(x[u] + bias);
#pragma unroll
        for (int o = 1; o < 64; o <<= 1) { const float y = __builtin_bit_cast(float, __builtin_amdgcn_ds_bpermute((lane - o) << 2, __builtin_bit_cast(int, v))); if (lane >= o) v += y; }
        v += carry; vals[u] = v; carry = __builtin_bit_cast(float, __builtin_amdgcn_readlane(__builtin_bit_cast(int, v), 63)); }
    LAS float* tot = (LAS float*)lds;
    if (lane == 0) tot[wave] = carry;
    __syncthreads();
    float prefix = 0.f;
    for (int w = 0; w < wave; ++w) prefix += tot[w];
#pragma unroll
    for (int u = 0; u < 8; ++u) cp[64 * u] = (vals[u] + prefix) * -8.f;
    __syncthreads();
}
__device__ __forceinline__ void nsa_select(const bf16* PROJ, const bf16* KC, unsigned long long* SEL, int gw, int NGW, int lane) {
    for (int it = gw; it < BATCH * 2 * SEQ; it += NGW) {
        const int b = it >> 13, g = (it >> 12) & 1, t = it & 4095; const size_t row = (size_t)b * SEQ + t;
        int ncv = t >= 31 ? ((t - 31) >> 4) + 1 : 0; ncv = ncv > 255 ? 255 : ncv;
        float pg[4] = {0.f, 0.f, 0.f, 0.f};
        const bf16* kcb = KC + (size_t)((0 * BATCH + b) * 2 + g) * 256 * 64;
        if (ncv > 0) {
#pragma unroll 1
            for (int jh = 0; jh < 4; ++jh) { const int h = 4 * g + jh; const float slope = exp2f(-(float)(h + 1));
                const v4u* qp = (const v4u*)(PROJ + row * NINP + C_NSAQ + h * 64);
                float s[4] = {0.f, 0.f, 0.f, 0.f}; float mx = -1e30f;
                const int cl = 4 * lane + 3 < 255 ? 4 * lane + 3 : 254;
#pragma unroll 1
                for (int ch = 0; ch < 8; ++ch) { const v4u qw = qp[ch];
#pragma unroll
                    for (int i = 0; i < 4; ++i) { const int cc = i < 3 ? 4 * lane + i : cl; const v4u w = ((const v4u*)(kcb + (size_t)cc * 64))[ch];
                        s[i] += lo16(qw.x) * lo16(w.x) + hi16(qw.x) * hi16(w.x) + lo16(qw.y) * lo16(w.y) + hi16(qw.y) * hi16(w.y) + lo16(qw.z) * lo16(w.z) + hi16(qw.z) * hi16(w.z) + lo16(qw.w) * lo16(w.w) + hi16(qw.w) * hi16(w.w); } }
#pragma unroll
                for (int i = 0; i < 4; ++i) { const int c = 4 * lane + i; const float d = s[i] * 0.125f - slope * (float)(t - 16 * c - 31); s[i] = c < ncv ? d : -1e30f; mx = fmaxf(mx, s[i]); }
                mx = wave_max(mx); float sum = 0.f;
#pragma unroll
                for (int i = 0; i < 4; ++i) { s[i] = (4 * lane + i) < ncv ? __expf(s[i] - mx) : 0.f; sum += s[i]; }
                sum = wave_sum(sum); const float inv = 1.f / sum;
#pragma unroll
                for (int i = 0; i < 4; ++i) pg[i] += s[i] * inv;
            }
        }
        float pm1 = __shfl_up(pg[3], 1); if (lane == 0) pm1 = 0.f;
        const float imp = pm1 + 2.f * (pg[0] + pg[1] + pg[2]) + pg[3];
        const bool causal = 64 * lane <= t; const int cur = t >> 6; const bool forced = lane == 0 || lane == cur || lane == cur - 1;
        const float score = causal ? (forced ? 1e4f : imp) : -1e30f;
        int rank = 0;
#pragma unroll 1
        for (int i0 = 0; i0 < 64; i0 += 8) {
#pragma unroll
            for (int ij = 0; ij < 8; ++ij) { const int i = i0 + ij; const float v = __shfl(score, i); rank += (v > score || (v == score && i < lane)) ? 1 : 0; } }
        const unsigned long long mask = __ballot(rank < 16 && causal);
        if (lane == 0) SEL[(size_t)(b * 2 + g) * SEQ + t] = mask;
    }
}
__device__ __forceinline__ void fox_item(const bf16* PROJ, const float* CUM, bf16* O, int bh, int chunk, int lane) {
    const int b = bh / 7, h = bh % 7, half = lane & 1, t = chunk * 32 + (lane >> 1), tmax = chunk * 32 + 31; const size_t row = (size_t)b * SEQ + t;
    float q[64]; load_row64(PROJ + row * NINP + C_FOXQ + h * 64, q);
    const float* cum = CUM + (size_t)(b * 7 + h) * SEQ; const float cq = cum[t];
    float m = -1e30f, l = 0.f, o[32];
#pragma unroll
    for (int d = 0; d < 32; ++d) o[d] = 0.f;
    const bf16* kb = PROJ + (size_t)b * SEQ * NINP + C_FOXK + h * 64; const bf16* vb = PROJ + (size_t)b * SEQ * NINP + C_FOXV + h * 64 + half * 32;
    for (int s = 0; s <= tmax; ++s) { const float sc = dot64(q, kb + (size_t)s * NINP) * 0.125f + cq - cum[s]; att_update<4>(sc, s <= t, vb + (size_t)s * NINP, m, l, o); }
    store_row<4>(O + row * DM + O_FOX + h * 64 + half * 32, o, 1.f / l);
}
__device__ __forceinline__ void nsa_item(const bf16* PROJ, const bf16* KC, const unsigned long long* SEL, bf16* O, int bh, int chunk, int lane) {
    const int b = bh >> 3, h = bh & 7, g = h >> 2, half = lane & 1, t0 = chunk * 32, t = t0 + (lane >> 1), tmax = t0 + 31; const size_t row = (size_t)b * SEQ + t;
    const float slope = exp2f(-(float)(h + 1));
    float q[64]; load_row64(PROJ + row * NINP + C_NSAQ + h * 64, q);
    const float g0 = sigmoidf_(bf2f(PROJ[row * NINP + C_GATE + h * 3 + 0])), g1 = sigmoidf_(bf2f(PROJ[row * NINP + C_GATE + h * 3 + 1])), g2 = sigmoidf_(bf2f(PROJ[row * NINP + C_GATE + h * 3 + 2]));
    float res[32], o[32]; float m, l;
#pragma unroll
    for (int d = 0; d < 32; ++d) res[d] = 0.f;
    {
        int ncv = t >= 31 ? ((t - 31) >> 4) + 1 : 0; ncv = ncv > 255 ? 255 : ncv;
        int ncm = tmax >= 31 ? ((tmax - 31) >> 4) + 1 : 0; ncm = ncm > 255 ? 255 : ncm;
        const bf16* kc = KC + (size_t)((0 * BATCH + b) * 2 + g) * 256 * 64; const bf16* vc = KC + (size_t)((1 * BATCH + b) * 2 + g) * 256 * 64 + half * 32;
        m = -1e30f; l = 0.f;
#pragma unroll
        for (int d = 0; d < 32; ++d) o[d] = 0.f;
        for (int c = 0; c < ncm; ++c) { const float sc = dot64(q, kc + (size_t)c * 64) * 0.125f - slope * (float)(t - 16 * c - 31); att_update<4>(sc, c < ncv, vc + (size_t)c * 64, m, l, o); }
        const float w = l > 0.f ? g0 / l : 0.f;
#pragma unroll
        for (int d = 0; d < 32; ++d) res[d] = fmaf(w, o[d], res[d]);
    }
    {
        const unsigned long long mask = SEL[(size_t)(b * 2 + g) * SEQ + t];
        const bf16* kb = PROJ + (size_t)b * SEQ * NINP + C_SLCK + g * 64; const bf16* vb = PROJ + (size_t)b * SEQ * NINP + C_SLCV + g * 64 + half * 32;
        m = -1e30f; l = 0.f;
#pragma unroll
        for (int d = 0; d < 32; ++d) o[d] = 0.f;
        for (int jb = 0; jb <= (tmax >> 6); ++jb) { const bool bit = (mask >> jb) & 1ull; if (!__any(bit ? 1 : 0)) continue;
            for (int s = 64 * jb; s < 64 * jb + 64; ++s) { const float sc = dot64(q, kb + (size_t)s * NINP) * 0.125f - slope * (float)(t - s); att_update<4>(sc, bit && s <= t, vb + (size_t)s * NINP, m, l, o); } }
        const float w = l > 0.f ? g1 / l : 0.f;
#pragma unroll
        for (int d = 0; d < 32; ++d) res[d] = fmaf(w, o[d], res[d]);
    }
    {
        const bf16* kb = PROJ + (size_t)b * SEQ * NINP + C_WINK + g * 64; const bf16* vb = PROJ + (size_t)b * SEQ * NINP + C_WINV + g * 64 + half * 32;
        m = -1e30f; l = 0.f;
#pragma unroll
        for (int d = 0; d < 32; ++d) o[d] = 0.f;
        const int s0 = t0 - 511 > 0 ? t0 - 511 : 0;
        for (int s = s0; s <= tmax; ++s) { const float sc = dot64(q, kb + (size_t)s * NINP) * 0.125f - slope * (float)(t - s); att_update<4>(sc, s <= t && t - s < 512, vb + (size_t)s * NINP, m, l, o); }
        const float w = l > 0.f ? g2 / l : 0.f;
#pragma unroll
        for (int d = 0; d < 32; ++d) res[d] = fmaf(w, o[d], res[d]);
    }
    store_row<4>(O + row * DM + O_NSA + h * 64 + half * 32, res, 1.f);
}
__device__ __forceinline__ void dil_item(const bf16* PROJ, bf16* O, int bj, int chunk, int lane) {
    const int b = bj / 3, j = bj % 3, half = lane & 1, t = chunk * 32 + (lane >> 1); const size_t row = (size_t)b * SEQ + t;
    float lse[3]; float q[64];
#pragma unroll
    for (int g = 0; g < 3; ++g) { const int head = 3 * g + j, dil = g == 0 ? 1 : (g == 1 ? 4 : 16); const float slope = exp2f(-8.f * (float)(head + 1) / 9.f);
        load_row64(PROJ + row * NINP + C_DILQ + head * 64, q);
        const bf16* kb = PROJ + (size_t)b * SEQ * NINP + C_DILK + head * 64;
        float m = -1e30f, l = 0.f;
        for (int k = 0; k <= 128; ++k) { const int s = t - k * dil; const bool valid = s >= 0; const int sc_ = valid ? s : 0;
            const float sc = dot64(q, kb + (size_t)sc_ * NINP) * 0.125f - slope * (float)(k * dil);
            if (valid) { if (sc > m) { l *= __expf(m - sc); m = sc; } l += __expf(sc - m); } }
        lse[g] = m + __logf(l);
    }
    const float mx = fmaxf(lse[0], fmaxf(lse[1], lse[2]));
    const float e0 = __expf(lse[0] - mx), e1 = __expf(lse[1] - mx), e2 = __expf(lse[2] - mx), inv = 1.f / (e0 + e1 + e2);
    float o[32];
#pragma unroll
    for (int g = 0; g < 3; ++g) { const int head = 3 * g + j, dil = g == 0 ? 1 : (g == 1 ? 4 : 16); const float slope = exp2f(-8.f * (float)(head + 1) / 9.f);
        load_row64(PROJ + row * NINP + C_DILQ + head * 64, q);
        const bf16* kb = PROJ + (size_t)b * SEQ * NINP + C_DILK + head * 64; const bf16* vb = PROJ + (size_t)b * SEQ * NINP + C_DILV + head * 64 + half * 32;
#pragma unroll
        for (int d = 0; d < 32; ++d) o[d] = 0.f;
        for (int k = 0; k <= 128; ++k) { const int s = t - k * dil; const bool valid = s >= 0; const int sc_ = valid ? s : 0;
            const float sc = dot64(q, kb + (size_t)sc_ * NINP) * 0.125f - slope * (float)(k * dil);
            if (valid) { const float p = __expf(sc - lse[g]); const bf16* vrow = vb + (size_t)sc_ * NINP;
#pragma unroll
                for (int c = 0; c < 4; ++c) { const v4u w = ((const v4u*)vrow)[c];
                    o[8 * c + 0] = fmaf(p, lo16(w.x), o[8 * c + 0]); o[8 * c + 1] = fmaf(p, hi16(w.x), o[8 * c + 1]); o[8 * c + 2] = fmaf(p, lo16(w.y), o[8 * c + 2]); o[8 * c + 3] = fmaf(p, hi16(w.y), o[8 * c + 3]);
                    o[8 * c + 4] = fmaf(p, lo16(w.z), o[8 * c + 4]); o[8 * c + 5] = fmaf(p, hi16(w.z), o[8 * c + 5]); o[8 * c + 6] = fmaf(p, lo16(w.w), o[8 * c + 6]); o[8 * c + 7] = fmaf(p, hi16(w.w), o[8 * c + 7]); } } }
        const float wg = (g == 0 ? e0 : (g == 1 ? e1 : e2)) * inv;
        store_row<4>(O + row * DM + O_DIL + head * 64 + half * 32, o, wg);
    }
}
__device__ __forceinline__ void dif_item(const bf16* PROJ, bf16* O, float lam, const float* subg, float oscale, int bh, int chunk, int lane) {
    const int b = bh >> 2, h = bh & 3, qi = lane >> 3, mm = (lane >> 2) & 1, qt = lane & 3, t = chunk * 8 + qi, tmax = chunk * 8 + 7; const size_t row = (size_t)b * SEQ + t;
    const float slope = exp2f(-2.f * (float)(h + 1));
    float q[64]; load_row64(PROJ + row * NINP + C_DIFQ + h * 128 + mm * 64, q);
    const bf16* kb = PROJ + (size_t)b * SEQ * NINP + C_DIFK + h * 128 + mm * 64; const bf16* vb = PROJ + (size_t)b * SEQ * NINP + C_DIFV + h * 128 + qt * 32;
    float m = -1e30f, l = 0.f, o[32];
#pragma unroll
    for (int d = 0; d < 32; ++d) o[d] = 0.f;
    for (int s = 0; s <= tmax; ++s) { const float sc = dot64(q, kb + (size_t)s * NINP) * 0.125f - slope * (float)(t - s); att_update<4>(sc, s <= t, vb + (size_t)s * NINP, m, l, o); }
    const float inv = 1.f / l; float ss = 0.f;
#pragma unroll
    for (int d = 0; d < 32; ++d) { const float mine = o[d] * inv; const float other = __shfl_xor(mine, 4); const float r = mm == 0 ? mine - lam * other : other - lam * mine; o[d] = r; ss = fmaf(r, r, ss); }
    ss += __shfl_xor(ss, 1); ss += __shfl_xor(ss, 2);
    const float rs = rsqrtf(ss * (1.f / 128.f) + 1e-6f) * oscale;
#pragma unroll
    for (int d = 0; d < 32; ++d) o[d] *= rs * subg[qt * 32 + d];
    if (mm == 0) store_row<4>(O + row * DM + O_DIF + h * 128 + qt * 32, o, 1.f);
}
constexpr int NI_FOX = BATCH * 7 * 128, NI_DIF = BATCH * 4 * 128, NI_NSA = BATCH * 8 * 128, NI_DIL = BATCH * 3 * 16 * 8, NI_ATT = NI_FOX + NI_DIF + NI_NSA + NI_DIL;

typedef short bf16x8 __attribute__((ext_vector_type(8)));
typedef float f32x16 __attribute__((ext_vector_type(16)));
typedef float f32x2_t __attribute__((ext_vector_type(2)));
typedef __bf16 bf16x2_t __attribute__((ext_vector_type(2)));
__device__ __forceinline__ unsigned cvtpk(float lo, float hi) { f32x2_t v = {lo, hi}; bf16x2_t b = __builtin_convertvector(v, bf16x2_t); return __builtin_bit_cast(unsigned, b); }
#define MFMA32(a, b, c) __builtin_amdgcn_mfma_f32_32x32x16_bf16((a), (b), (c), 0, 0, 0)
__device__ __forceinline__ int fresh_lane() { int l = (int)__builtin_amdgcn_mbcnt_hi(~0u, __builtin_amdgcn_mbcnt_lo(~0u, 0u)); asm volatile("" : "+v"(l)); return l; }
constexpr float LOG2E = 1.4426950408889634f, QK_SCL = 0.125f * 1.4426950408889634f;
constexpr float NEG_BIG = -1e30f;

constexpr int NHS = 28, VTB_KB = SEQ / 32;
__device__ __forceinline__ int hs_col(int hs) { return hs < 7 ? C_FOXV + 64 * hs : hs < 9 ? C_SLCV + 64 * (hs - 7) : hs < 11 ? C_WINV + 64 * (hs - 9) : hs < 20 ? C_DILV + 64 * (hs - 11) : C_DIFV + 64 * (hs - 20); }
__device__ __forceinline__ int hs_dil(int hs) { return (hs >= 14 && hs < 17) ? 4 : ((hs >= 17 && hs < 20) ? 16 : 1); }
__device__ __forceinline__ size_t vtb_off(int b, int hs, int kb) { return ((size_t)(b * NHS + hs) * VTB_KB + kb) * 4096; }
__device__ __forceinline__ int vtb_key_of_pos(int p) { const int s = p >> 4, h = (p >> 3) & 1, j = p & 7; return 16 * s + 8 * (j >> 2) + 4 * h + (j & 3); }
__device__ __forceinline__ void vprep_item(const bf16* PROJ, unsigned char* VTB, int item, LAS unsigned* s32, int lane) {
    const int kb = item % VTB_KB, hs = (item / VTB_KB) % NHS, b = item / (VTB_KB * NHS);
    const int dil = hs_dil(hs), col = hs_col(hs), tk = lane & 31, half = lane >> 5;
    const int pos = kb * 32 + tk, seg = SEQ / dil, token = pos / seg + dil * (pos % seg);
    const v4u* src = (const v4u*)(PROJ + ((size_t)b * SEQ + token) * NINP + col + 32 * half);
#pragma unroll
    for (int i = 0; i < 4; ++i) { const v4u w = src[i]; LAS unsigned* d = s32 + tk * 33 + 16 * half + 4 * i; d[0] = w.x; d[1] = w.y; d[2] = w.z; d[3] = w.w; }
    LDS_WAIT(); asm volatile("" ::: "memory");
    const LAS unsigned short* s16 = (const LAS unsigned short*)s32;
    unsigned out[16];
#pragma unroll
    for (int p = 0; p < 32; p += 2) { const unsigned lo = s16[vtb_key_of_pos(p) * 66 + 32 * half + tk], hi = s16[vtb_key_of_pos(p + 1) * 66 + 32 * half + tk]; out[p >> 1] = lo | (hi << 16); }
    v4u* dst = (v4u*)(VTB + vtb_off(b, hs, kb) + half * 2048 + tk * 64);
#pragma unroll
    for (int i = 0; i < 4; ++i) { v4u w; w.x = out[4 * i]; w.y = out[4 * i + 1]; w.z = out[4 * i + 2]; w.w = out[4 * i + 3]; dst[i] = w; }
    LDS_WAIT(); asm volatile("" ::: "memory");
}
__device__ __forceinline__ void load_qfrag(const bf16* qrow_h  , bf16x8 (&qf)[4]) {
#pragma unroll
    for (int ks = 0; ks < 4; ++ks) qf[ks] = *(const GAS bf16x8*)(qrow_h + 16 * ks);
}
__device__ __forceinline__ void load_k(const bf16* kp, bf16x8 (&kf)[4]) {
#pragma unroll
    for (int ks = 0; ks < 4; ++ks) kf[ks] = *(const GAS bf16x8*)(kp + 16 * ks);
}
template <int NDT> __device__ __forceinline__ void load_v(const unsigned char* vp0, const unsigned char* vp1, bf16x8 (&vf)[2 * NDT]) {
#pragma unroll
    for (int dt = 0; dt < NDT; ++dt) { const unsigned char* vp = (dt < 2 ? vp0 : vp1) + (dt & 1) * 2048; vf[2 * dt] = *(const GAS bf16x8*)vp; vf[2 * dt + 1] = *(const GAS bf16x8*)(vp + 32); }
}
template <int NDT>
__device__ __forceinline__ void store_ot(bf16* orow  , const f32x16 (&o)[NDT], float scale, int hh) {
#pragma unroll
    for (int dt = 0; dt < NDT; ++dt)
#pragma unroll
        for (int g = 0; g < 4; ++g) { v2u w; w.x = cvtpk(o[dt][4 * g] * scale, o[dt][4 * g + 1] * scale); w.y = cvtpk(o[dt][4 * g + 2] * scale, o[dt][4 * g + 3] * scale);
            *(v2u*)(orow + 32 * dt + 8 * g + 4 * hh) = w; }
}
template <int NDT> __device__ __forceinline__ void zero_ot(f32x16 (&o)[NDT]) {
#pragma unroll
    for (int dt = 0; dt < NDT; ++dt)
#pragma unroll
        for (int r = 0; r < 16; ++r) o[dt][r] = 0.f;
}
#define CR(r) (((r) & 3) + 8 * ((r) >> 2))
struct AlibiBase { float g, tadd; int hh; f32x16 cv;
    __device__ __forceinline__ void setup(float g_, int hh_) { g = g_; hh = hh_; asm volatile("" : "+v"(hh_));
#pragma unroll
        for (int r = 0; r < 16; ++r) cv[r] = g_ * (1.f / QK_SCL) * (float)(CR(r) + 4 * hh_); }
    __device__ __forceinline__ void set_base(float qrel  ) { tadd = -g * qrel; }
    __device__ __forceinline__ void fetch(int) {} __device__ __forceinline__ void rotate() {} __device__ __forceinline__ bool lane_on() const { return true; }
    __device__ __forceinline__ const f32x16& c1() const { return cv; } __device__ __forceinline__ const f32x16& c0() const { return cv; } __device__ __forceinline__ void fetch2(int) {} };
struct AlibiCausal : AlibiBase { int tq, t0;
    __device__ __forceinline__ void begin(int k0) { set_base((float)(tq - k0)); }
    __device__ __forceinline__ bool valid(int kk) const { return kk <= tq; }
    __device__ __forceinline__ bool needs_mask(int k0) const { return k0 + 31 > t0; } };
struct WinBias : AlibiBase { int tq, t0;
    __device__ __forceinline__ void begin(int k0) { set_base((float)(tq - k0)); }
    __device__ __forceinline__ bool valid(int kk) const { return kk <= tq && tq - kk < 512; }
    __device__ __forceinline__ bool needs_mask(int k0) const { return k0 + 31 > t0 || t0 + 31 - k0 >= 512; } };
struct SlcBias : AlibiBase { int tq; bool bit;
    __device__ __forceinline__ void begin(int k0) { set_base((float)(tq - k0)); }
    __device__ __forceinline__ bool valid(int kk) const { return bit && kk <= tq; }
    __device__ __forceinline__ bool lane_on() const { return bit; }
    __device__ __forceinline__ bool needs_mask(int) const { return true; } };
struct CmpBias : AlibiBase { int tq, ncv, ncv_min;
    __device__ __forceinline__ void begin(int k0) { set_base((float)(tq - 31 - 16 * k0) * (1.f / 16.f)); }
    __device__ __forceinline__ bool valid(int kk) const { return kk < ncv; }
    __device__ __forceinline__ bool needs_mask(int k0) const { return k0 + 31 >= ncv_min; } };
struct DilBias : AlibiBase { int iq;
    __device__ __forceinline__ void begin(int k0) { set_base((float)(iq - k0)); }
    __device__ __forceinline__ bool valid(int kk) const { return kk <= iq && iq - kk <= 128; }
    __device__ __forceinline__ bool needs_mask(int) const { return true; } };
struct FoxBias { const float* cum2; float tadd; int tq, t0, hh; f32x16 cvA, cvB;
    __device__ __forceinline__ void fetch2(int st) {
#pragma unroll
        for (int g = 0; g < 4; ++g) { const f32x4 a = *(const GAS f32x4*)(cum2 + 64 * st + 32 + 8 * g + 4 * hh), b = *(const GAS f32x4*)(cum2 + 64 * st + 8 * g + 4 * hh);
            cvA[4 * g] = a.x; cvA[4 * g + 1] = a.y; cvA[4 * g + 2] = a.z; cvA[4 * g + 3] = a.w; cvB[4 * g] = b.x; cvB[4 * g + 1] = b.y; cvB[4 * g + 2] = b.z; cvB[4 * g + 3] = b.w; } }
    __device__ __forceinline__ const f32x16& c1() const { return cvA; } __device__ __forceinline__ const f32x16& c0() const { return cvB; }
    __device__ __forceinline__ void begin(int) {} __device__ __forceinline__ bool lane_on() const { return true; }
    __device__ __forceinline__ bool valid(int kk) const { return kk <= tq; }
    __device__ __forceinline__ bool needs_mask(int k0) const { return k0 + 31 > t0; } };
struct CmpSel { float slope2; int tq, ncv;
    __device__ __forceinline__ float operator()(float raw, int kk, int) const { return kk < ncv ? fmaf(raw, QK_SCL, -slope2 * (float)(tq - 16 * kk - 31)) : NEG_BIG; } };

template <int NDT, class F>
__device__ __forceinline__ void softmax_body(f32x16& s, const F& f, int k0, int hh, f32x16 (&o)[NDT], float& m, float& l, bf16x8& pf0, bf16x8& pf1, const int MASK) {
    float mx = NEG_BIG;
    if (MASK == 1) {
#pragma unroll
        for (int r = 0; r < 16; ++r) s[r] = f.valid(k0 + CR(r) + 4 * hh) ? s[r] : NEG_BIG; }
#pragma unroll
    for (int r = 0; r < 16; ++r) mx = fmaxf(mx, s[r]);
    mx = fmaf(mx, QK_SCL, f.tadd);
    const bool on = MASK != 2 || f.lane_on();
    mx = on ? mx : NEG_BIG;
    mx = half_max(mx);
    if (__ballot(mx > m) != 0ull) { const float mn = fmaxf(m, mx), alpha = __builtin_amdgcn_exp2f(m - mn); m = mn; l *= alpha;
#pragma unroll
        for (int dt = 0; dt < NDT; ++dt) o[dt] = o[dt] * alpha; }
    const float me = fmaxf(m, -1e29f);
    const float off = on ? f.tadd - me : NEG_BIG;
    const f32x2_t sc2 = {QK_SCL, QK_SCL}, of2 = {off, off}; f32x2_t ps2 = {0.f, 0.f};
#pragma unroll
    for (int r = 0; r < 16; r += 2) { f32x2_t a = {s[r], s[r + 1]}; a = __builtin_elementwise_fma(a, sc2, of2);
        f32x2_t p; p.x = __builtin_amdgcn_exp2f(a.x); p.y = __builtin_amdgcn_exp2f(a.y); s[r] = p.x; s[r + 1] = p.y; ps2 += p; }
    l += ps2.x + ps2.y;
    v4u p0, p1;
    p0.x = cvtpk(s[0], s[1]); p0.y = cvtpk(s[2], s[3]); p0.z = cvtpk(s[4], s[5]); p0.w = cvtpk(s[6], s[7]);
    p1.x = cvtpk(s[8], s[9]); p1.y = cvtpk(s[10], s[11]); p1.z = cvtpk(s[12], s[13]); p1.w = cvtpk(s[14], s[15]);
    pf0 = __builtin_bit_cast(bf16x8, p0); pf1 = __builtin_bit_cast(bf16x8, p1);
}
template <int NDT, int MASK, class F>
__device__ __forceinline__ void softmax_tile(f32x16& s, const F& f, int k0, int hh, f32x16 (&o)[NDT], float& m, float& l, bf16x8& pf0, bf16x8& pf1) { softmax_body<NDT>(s, f, k0, hh, o, m, l, pf0, pf1, MASK); }
template <int NDT, bool MASK, class F>
__device__ __forceinline__ void att_compute(const bf16x8 (&qf)[4], const bf16x8 (&kf)[4], const bf16x8 (&vf)[2 * NDT], const F& f, int k0, int hh, f32x16 (&o)[NDT], float& m, float& l) {
    f32x16 s = MFMA32(kf[0], qf[0], f.cv);
#pragma unroll
    for (int ks = 1; ks < 4; ++ks) s = MFMA32(kf[ks], qf[ks], s);
    bf16x8 pf0, pf1; softmax_tile<NDT, MASK>(s, f, k0, hh, o, m, l, pf0, pf1);
#pragma unroll
    for (int dt = 0; dt < NDT; ++dt) { o[dt] = MFMA32(vf[2 * dt], pf0, o[dt]); o[dt] = MFMA32(vf[2 * dt + 1], pf1, o[dt]); }
}
template <int NDT, bool MASK, class F>
__device__ __forceinline__ void att_compute_lds(const bf16x8 (&qf)[4], const LAS unsigned char* cur, int fk, int fv, const F& f, int k0, int hh, f32x16 (&o)[NDT], float& m, float& l) {
    f32x16 s;
#pragma unroll
    for (int ks = 0; ks < 4; ++ks) { const bf16x8 kf = *(const LAS bf16x8*)(cur + (fk ^ (ks << 5))); s = MFMA32(kf, qf[ks], ks == 0 ? f.cv : s); }
    bf16x8 va0 = *(const LAS bf16x8*)(cur + fv), va1 = *(const LAS bf16x8*)(cur + (fv ^ 32));
    __builtin_amdgcn_sched_barrier(0);
    bf16x8 pf0, pf1; softmax_tile<NDT, MASK>(s, f, k0, hh, o, m, l, pf0, pf1);
#pragma unroll
    for (int dt = 0; dt < NDT; ++dt) { bf16x8 vb0 = va0, vb1 = va1;
        if (dt + 1 < NDT) { vb0 = *(const LAS bf16x8*)(cur + (dt + 1) * 2048 + fv); vb1 = *(const LAS bf16x8*)(cur + (dt + 1) * 2048 + (fv ^ 32)); __builtin_amdgcn_sched_barrier(0); }
        o[dt] = MFMA32(va0, pf0, o[dt]); o[dt] = MFMA32(va1, pf1, o[dt]); va0 = vb0; va1 = vb1; }
}
template <int NDT, class F>
__device__ __forceinline__ void att_range(const bf16x8 (&qf)[4], const bf16* kb, size_t kts, const unsigned char* vb0, const unsigned char* vb1, F& f, int kt0, int kt1, int hh, f32x16 (&o)[NDT], float& m, float& l) {
#pragma unroll 1
    for (int kt = kt1; kt >= kt0; --kt) {
        bf16x8 kf[4], vf[2 * NDT];
        f.fetch(32 * kt); load_k(kb + (size_t)kt * kts, kf); load_v<NDT>(vb0 + (size_t)kt * 4096, vb1 + (size_t)kt * 4096, vf);
        f.rotate(); f.begin(32 * kt);
        if (f.needs_mask(32 * kt)) att_compute<NDT, true>(qf, kf, vf, f, 32 * kt, hh, o, m, l);
        else att_compute<NDT, false>(qf, kf, vf, f, 32 * kt, hh, o, m, l);
    }
}
__device__ __forceinline__ int swz_v(int off) { const int d = (off >> 6) & 31; return (off & ~0x30) | ((((off >> 4) & 3) ^ ((d >> 2) & 3)) << 4); }
template <int K> __device__ __forceinline__ int xor_now(int x) { if (K != 0) asm volatile("v_xor_b32 %0, %1, %0" : "+v"(x) : "n"(K)); return x; }
struct WvStream { const unsigned char* kbase; const unsigned char* vbase; size_t ts; unsigned rs8, kofs, vofs; int fk, fv;
    __device__ __forceinline__ void setup(const void* kb0, size_t rs, const void* vb0, int lane) { asm volatile("" : "+v"(lane)); const int kr = lane & 31, hh = lane >> 5;
        kbase = (const unsigned char*)kb0; vbase = (const unsigned char*)vb0; ts = 32 * rs; rs8 = (unsigned)(8 * rs);
        kofs = (unsigned)(lane >> 3) * (unsigned)rs + (unsigned)((((lane & 7) ^ (lane >> 4)) << 4));
        vofs = (unsigned)swz_v(lane * 16);
        fk = kr * 128 + ((hh ^ ((kr >> 1) & 7)) << 4); fv = 4096 + kr * 64 + ((hh ^ ((kr >> 2) & 3)) << 4); }
    static __device__ __forceinline__ const unsigned char* uni(const unsigned char* p) { unsigned long long v = (unsigned long long)p; asm volatile("" : "+s"(v)); return (const unsigned char*)v; }
    __device__ __forceinline__ void dma_k(int kt, LAS unsigned char* slot) const { const unsigned char* g = kbase + (size_t)kt * ts;
#pragma unroll
        for (int i = 0; i < 4; ++i) __builtin_amdgcn_global_load_lds((const unsigned*)(uni(g + (size_t)i * rs8) + ((i & 1) ? (unsigned)xor_now<64>((int)kofs) : kofs)), (LAS unsigned*)(slot + i * 1024), 16, 0, 0); }
    __device__ __forceinline__ void dma_v(int kt, LAS unsigned char* slot) const { const unsigned char* g = vbase + (size_t)kt * 4096;
#pragma unroll
        for (int i = 0; i < 4; ++i) __builtin_amdgcn_global_load_lds((const unsigned*)(uni(g + i * 1024) + vofs), (LAS unsigned*)(slot + 4096 + i * 1024), 16, 0, 0); } };
#define VMW(n) asm volatile("s_waitcnt vmcnt(" #n ")" ::: "memory")
struct RangeIt { int kt, kt0; __device__ __forceinline__ int next() { const int r = kt >= kt0 ? kt : -1; --kt; return r; } };
template <class F> struct RangePre { F& f; static constexpr bool LANE_MODE = false; __device__ __forceinline__ int operator()(int kt) { f.begin(32 * kt); return f.needs_mask(32 * kt) ? 1 : 0; } };
template <int NDT, class F>
__device__ __forceinline__ void stream_tile(const bf16x8 (&qf)[4], const WvStream& st, LAS unsigned char* cur, LAS unsigned char* nxt, const F& f, f32x16& s, int t0, int t1, int t2, int t3, int hh, f32x16 (&o)[NDT], float& m, float& l, int msk) {
    f32x16 sn;
    if (t1 >= 0) {
        if (t2 >= 0) VMW(12); else VMW(8);
#pragma unroll
        for (int ks = 0; ks < 4; ++ks) { const bf16x8 kf = *(const LAS bf16x8*)(nxt + (ks == 0 ? st.fk : ks == 1 ? xor_now<32>(st.fk) : ks == 2 ? xor_now<64>(st.fk) : xor_now<96>(st.fk))); sn = MFMA32(kf, qf[ks], ks == 0 ? f.cv : sn); }
        if (t3 >= 0) st.dma_k(t3, nxt);
        __builtin_amdgcn_sched_barrier(0);
    }
    bf16x8 pf0, pf1; softmax_body<NDT>(s, f, 32 * t0, hh, o, m, l, pf0, pf1, msk);
    v4u tie = __builtin_bit_cast(v4u, pf0);
    if (t3 >= 0) asm volatile("s_waitcnt vmcnt(12)" : "+v"(tie.x) :: "memory");
    else if (t2 >= 0) asm volatile("s_waitcnt vmcnt(8)" : "+v"(tie.x) :: "memory");
    else if (t1 >= 0) asm volatile("s_waitcnt vmcnt(4)" : "+v"(tie.x) :: "memory");
    else asm volatile("s_waitcnt vmcnt(0)" : "+v"(tie.x) :: "memory");
    pf0 = __builtin_bit_cast(bf16x8, tie);
#pragma unroll
    for (int dt = 0; dt < NDT; ++dt) { const bf16x8 vf0 = *(const LAS bf16x8*)(cur + dt * 2048 + st.fv), vf1 = *(const LAS bf16x8*)(cur + dt * 2048 + xor_now<32>(st.fv));
        o[dt] = MFMA32(vf0, pf0, o[dt]); o[dt] = MFMA32(vf1, pf1, o[dt]); }
    if (t2 >= 0) st.dma_v(t2, cur);
    s = sn;
}
template <int NDT, class F, class It, class Pre>
__device__ __forceinline__ void att_stream(const bf16x8 (&qf)[4], const WvStream& st, LAS unsigned char* ring, F& f, It& it, Pre& pre, int hh, f32x16 (&o)[NDT], float& m, float& l) {
    static_assert(NDT == 2, "one 4 KiB V block per tile");
    int t0 = it.next(); if (t0 < 0) return;
    int t1 = it.next(), t2 = t1 >= 0 ? it.next() : -1, t3 = t2 >= 0 ? it.next() : -1;
    st.dma_k(t0, ring); if (t1 >= 0) st.dma_k(t1, ring + 8192); st.dma_v(t0, ring);
    if (t1 >= 0) VMW(8); else VMW(4);
    f32x16 s;
#pragma unroll
    for (int ks = 0; ks < 4; ++ks) { const bf16x8 kf = *(const LAS bf16x8*)(ring + (ks == 0 ? st.fk : ks == 1 ? xor_now<32>(st.fk) : ks == 2 ? xor_now<64>(st.fk) : xor_now<96>(st.fk))); s = MFMA32(kf, qf[ks], ks == 0 ? f.cv : s); }
    if (t2 >= 0) st.dma_k(t2, ring);
    if (t1 >= 0) st.dma_v(t1, ring + 8192);
    int par = 0;
#pragma unroll 1
    for (;;) {
        LAS unsigned char* cur = ring + par * 8192; LAS unsigned char* nxt = ring + (par ^ 1) * 8192;
        const int msk = pre(t0);
        stream_tile<NDT>(qf, st, cur, nxt, f, s, t0, t1, t2, t3, hh, o, m, l, msk);
        t0 = t1; t1 = t2; t2 = t3; t3 = t2 >= 0 ? it.next() : -1; par ^= 1;
        if (t0 < 0) break;
    }
}
struct SlcIt { unsigned long long um; int pend, tmax;
    __device__ __forceinline__ int next() { if (pend >= 0) { const int r = pend; pend = -1; return r; } if (um == 0ull) return -1;
        const int jb = 63 - __builtin_clzll(um); um &= ~(1ull << jb); if (32 * (2 * jb + 1) > tmax) return 2 * jb; pend = 2 * jb; return 2 * jb + 1; } };
struct SlcPre { SlcBias& f; unsigned long long mask; int t0; static constexpr bool LANE_MODE = true;
    __device__ __forceinline__ int operator()(int kt) { f.bit = (mask >> (kt >> 1)) & 1ull; const bool allsel = __ballot(f.bit ? 1 : 0) == ~0ull; f.begin(32 * kt);
        return 32 * kt + 31 <= t0 ? (allsel ? 0 : 2) : 1; } };
__device__ __forceinline__ int vtb_pos_of_key(int kk) { const int s = kk >> 4, w = kk & 15; return 16 * s + 8 * ((w >> 2) & 1) + 4 * (w >> 3) + (w & 3); }
__device__ __forceinline__ void nsa_item_mfma(const bf16* PROJ, const bf16* KC, const unsigned char* VCB, const unsigned char* VTB, const unsigned long long* SEL, bf16* O, LAS unsigned char* ring  , int bh, int qt, int lane) {
    lane = fresh_lane();
    const int b = bh >> 3, hd = bh & 7, g = hd >> 2, q = lane & 31, hh = lane >> 5, t0 = qt * 32, tq = t0 + q, tmax = t0 + 31;
#define NSA_ROW() ((size_t)b * SEQ + t0 + (fresh_lane() & 31))
    const float slope2 = exp2f(-(float)(hd + 1)) * LOG2E;
    bf16x8 qf[4]; load_qfrag(PROJ + NSA_ROW() * NINP + C_NSAQ + hd * 64 + 8 * hh, qf);
    f32x16 o[2]; unsigned res[16];
    {
        const unsigned long long mask = SEL[(size_t)(b * 2 + g) * SEQ + tq];
        SlcBias f; f.setup(slope2, hh); f.tq = tq;
        WvStream st; st.setup(PROJ + (size_t)b * SEQ * NINP + C_SLCK + g * 64, (size_t)NINP * 2, VTB + vtb_off(b, 7 + g, 0), lane);
        zero_ot<2>(o); float m = NEG_BIG, l = 0.f;
        unsigned ulo = (unsigned)mask, uhi = (unsigned)(mask >> 32);
        { ulo |= (unsigned)lx_i<1>((int)ulo); uhi |= (unsigned)lx_i<1>((int)uhi); ulo |= (unsigned)lx_i<2>((int)ulo); uhi |= (unsigned)lx_i<2>((int)uhi); ulo |= (unsigned)lx_i<4>((int)ulo); uhi |= (unsigned)lx_i<4>((int)uhi);
          ulo |= (unsigned)lx_i<8>((int)ulo); uhi |= (unsigned)lx_i<8>((int)uhi); ulo |= (unsigned)lx_i<16>((int)ulo); uhi |= (unsigned)lx_i<16>((int)uhi); }
        const unsigned long long um = (unsigned long long)(unsigned)__builtin_amdgcn_readfirstlane((int)ulo) | ((unsigned long long)(unsigned)__builtin_amdgcn_readfirstlane((int)uhi) << 32);
        SlcIt it; it.um = um; it.pend = -1; it.tmax = tmax; SlcPre pre{f, mask, t0};
        att_stream<2>(qf, st, ring, f, it, pre, hh, o, m, l);
        l = half_sum(l); const float g1 = sigmoidf_(bf2f(PROJ[NSA_ROW() * NINP + C_GATE + hd * 3 + 1])); const float w = l > 0.f ? g1 / l : 0.f;
#pragma unroll
        for (int dt = 0; dt < 2; ++dt)
#pragma unroll
            for (int r = 0; r < 16; r += 2) res[dt * 8 + (r >> 1)] = cvtpk(o[dt][r] * w, o[dt][r + 1] * w);
    }
    {
        WinBias f; f.setup(slope2, hh); f.tq = tq; f.t0 = t0;
        WvStream st; st.setup(PROJ + (size_t)b * SEQ * NINP + C_WINK + g * 64, (size_t)NINP * 2, VTB + vtb_off(b, 9 + g, 0), lane);
        zero_ot<2>(o); float m = NEG_BIG, l = 0.f;
        RangeIt it; it.kt = qt; it.kt0 = t0 >= 512 ? (t0 - 512) >> 5 : 0; RangePre<WinBias> pre{f};
        att_stream<2>(qf, st, ring, f, it, pre, hh, o, m, l);
        l = half_sum(l); const float g2 = sigmoidf_(bf2f(PROJ[NSA_ROW() * NINP + C_GATE + hd * 3 + 2])); const float w = l > 0.f ? g2 / l : 0.f;
#pragma unroll
        for (int dt = 0; dt < 2; ++dt)
#pragma unroll
            for (int r = 0; r < 16; r += 2) { const unsigned pr = res[dt * 8 + (r >> 1)]; res[dt * 8 + (r >> 1)] = cvtpk(fmaf(o[dt][r], w, lo16(pr)), fmaf(o[dt][r + 1], w, hi16(pr))); }
    }
    {
        CmpBias f; f.setup(16.f * slope2, hh); f.tq = tq; f.ncv = tq >= 31 ? ((tq - 31) >> 4) + 1 : 0; f.ncv = f.ncv > 255 ? 255 : f.ncv;
        f.ncv_min = t0 >= 31 ? ((t0 - 31) >> 4) + 1 : 0; f.ncv_min = f.ncv_min > 255 ? 255 : f.ncv_min;
        int ncm = tmax >= 31 ? ((tmax - 31) >> 4) + 1 : 0; ncm = ncm > 255 ? 255 : ncm;
        WvStream st; st.setup(KC + (size_t)((0 * BATCH + b) * 2 + g) * 256 * 64, 128, VCB + (size_t)(b * 2 + g) * 8 * 4096, lane);
        zero_ot<2>(o); float m = NEG_BIG, l = 0.f;
        RangeIt it; it.kt = ((ncm + 31) >> 5) - 1; it.kt0 = 0; RangePre<CmpBias> pre{f};
        att_stream<2>(qf, st, ring, f, it, pre, hh, o, m, l);
        l = half_sum(l); const float g0 = sigmoidf_(bf2f(PROJ[NSA_ROW() * NINP + C_GATE + hd * 3 + 0])); const float w = l > 0.f ? g0 / l : 0.f;
#pragma unroll
        for (int dt = 0; dt < 2; ++dt)
#pragma unroll
            for (int r = 0; r < 16; r += 2) { const unsigned pr = res[dt * 8 + (r >> 1)]; o[dt][r] = fmaf(o[dt][r], w, lo16(pr)); o[dt][r + 1] = fmaf(o[dt][r + 1], w, hi16(pr)); }
    }
    store_ot<2>(O + NSA_ROW() * DM + O_NSA + hd * 64, o, 1.f, fresh_lane() >> 5);
#undef NSA_ROW
}
struct QuadStream { const unsigned char* kbase; const unsigned char* vbase; size_t ts; unsigned kofs, vofs; int fk, fv, wi;
    __device__ __forceinline__ void setup(const void* kb0, size_t rs, const void* vb0, int lane, int wi_) { asm volatile("" : "+v"(lane)); const int kr = lane & 31, hh = lane >> 5; wi = wi_;
        kbase = (const unsigned char*)kb0 + (size_t)(8 * wi_) * rs; vbase = (const unsigned char*)vb0 + wi_ * 1024; ts = 32 * rs;
        const int row = 8 * wi_ + (lane >> 3);
        kofs = (unsigned)(lane >> 3) * (unsigned)rs + (unsigned)((((lane & 7) ^ ((row >> 1) & 7)) << 4));
        vofs = (unsigned)swz_v(lane * 16);
        fk = kr * 128 + ((hh ^ ((kr >> 1) & 7)) << 4); fv = 4096 + kr * 64 + ((hh ^ ((kr >> 2) & 3)) << 4); }
    __device__ __forceinline__ void dma(int kt, LAS unsigned char* slot) const {
        __builtin_amdgcn_global_load_lds((const unsigned*)(WvStream::uni(kbase + (size_t)kt * ts) + kofs), (LAS unsigned*)(slot + wi * 1024), 16, 0, 0);
        __builtin_amdgcn_global_load_lds((const unsigned*)(WvStream::uni(vbase + (size_t)kt * 4096) + vofs), (LAS unsigned*)(slot + 4096 + wi * 1024), 16, 0, 0); } };
constexpr int QD = 6;
template <class F, class It, class Pre>
__device__ __forceinline__ void quad_stream(const bf16x8 (&qf)[4], const QuadStream& st, LAS unsigned char* ring, F& f, It itC, It itD, Pre& pre, int n_own, int nsteps, int hh, f32x16 (&o)[2], float& m, float& l) {
    asm volatile("s_waitcnt vmcnt(0) lgkmcnt(0)" ::: "memory"); __builtin_amdgcn_s_barrier(); asm volatile("" ::: "memory");
    int lastv = 0;
#pragma unroll
    for (int i = 0; i < QD; ++i) { int t = itD.next(); if (t < 0) t = lastv; else lastv = t; st.dma(t, ring + i * 8192); }
#pragma unroll 1
    for (int k = 0; k < nsteps; ++k) {
        asm volatile("s_waitcnt vmcnt(10) lgkmcnt(0)" ::: "memory");
        __builtin_amdgcn_s_barrier(); asm volatile("" ::: "memory");
        { int t = itD.next(); if (t < 0) t = lastv; else lastv = t; st.dma(t, ring + ((k + QD) & 7) * 8192); }
        if (k < n_own) {
            const int t0 = itC.next(); const int msk = pre(t0);
            const LAS unsigned char* cur = ring + (k & 7) * 8192;
            f32x16 s;
#pragma unroll
            for (int ks = 0; ks < 4; ++ks) { const bf16x8 kf = *(const LAS bf16x8*)(cur + (st.fk ^ (ks << 5))); s = MFMA32(kf, qf[ks], ks == 0 ? f.cv : s); }
            bf16x8 pf0, pf1; softmax_body<2>(s, f, 32 * t0, hh, o, m, l, pf0, pf1, msk);
#pragma unroll
            for (int dt = 0; dt < 2; ++dt) { const bf16x8 vf0 = *(const LAS bf16x8*)(cur + dt * 2048 + st.fv), vf1 = *(const LAS bf16x8*)(cur + dt * 2048 + (st.fv ^ 32));
                o[dt] = MFMA32(vf0, pf0, o[dt]); o[dt] = MFMA32(vf1, pf1, o[dt]); }
        }
    }
}
__device__ __forceinline__ int slc_tiles(unsigned long long um, int t0) { return um == 0ull ? 0 : 2 * __builtin_popcountll(um) - ((t0 & 32) ? 0 : 1); }
__device__ __forceinline__ int win_tiles(int qt) { const int t0 = 32 * qt; return qt - (t0 >= 512 ? (t0 - 512) >> 5 : 0) + 1; }
__device__ __forceinline__ int cmp_tiles(int qt) { const int tmax = 32 * qt + 31; int ncm = tmax >= 31 ? ((tmax - 31) >> 4) + 1 : 0; ncm = ncm > 255 ? 255 : ncm; return (ncm + 31) >> 5; }
__device__ __forceinline__ unsigned long long tile_union(unsigned long long mask) {
    unsigned ulo = (unsigned)mask, uhi = (unsigned)(mask >> 32);
    ulo |= (unsigned)lx_i<1>((int)ulo); uhi |= (unsigned)lx_i<1>((int)uhi); ulo |= (unsigned)lx_i<2>((int)ulo); uhi |= (unsigned)lx_i<2>((int)uhi); ulo |= (unsigned)lx_i<4>((int)ulo); uhi |= (unsigned)lx_i<4>((int)uhi);
    ulo |= (unsigned)lx_i<8>((int)ulo); uhi |= (unsigned)lx_i<8>((int)uhi); ulo |= (unsigned)lx_i<16>((int)ulo); uhi |= (unsigned)lx_i<16>((int)uhi);
    return (unsigned long long)(unsigned)__builtin_amdgcn_readfirstlane((int)ulo) | ((unsigned long long)(unsigned)__builtin_amdgcn_readfirstlane((int)uhi) << 32); }
__device__ __forceinline__ void nsa_quad_item(const bf16* PROJ, const bf16* KC, const unsigned char* VCB, const unsigned char* VTB, const unsigned long long* SEL, bf16* O, LAS unsigned char* lds, int bg, int jp, int wave) {
    const int lane = fresh_lane();
    const int b = bg >> 1, g = bg & 1, wi = wave & 3, qd = wave >> 2, hd = 4 * g + wi, qt = 2 * jp + qd, qto = 2 * jp + (qd ^ 1), q = lane & 31, hh = lane >> 5, t0 = qt * 32, tq = t0 + q, tmax = t0 + 31;
    LAS unsigned char* ring = lds + qd * 65536;
#define NSA_ROW() ((size_t)b * SEQ + t0 + (fresh_lane() & 31))
    const float slope2 = exp2f(-(float)(hd + 1)) * LOG2E;
    bf16x8 qf[4]; load_qfrag(PROJ + NSA_ROW() * NINP + C_NSAQ + hd * 64 + 8 * hh, qf);
    f32x16 o[2]; unsigned res[16];
    {
        const unsigned long long mask = SEL[(size_t)(b * 2 + g) * SEQ + tq], masko = SEL[(size_t)(b * 2 + g) * SEQ + 32 * qto + q];
        const unsigned long long um = tile_union(mask), umo = tile_union(masko);
        const int n_own = slc_tiles(um, t0), n_oth = slc_tiles(umo, 32 * qto);
        SlcBias f; f.setup(slope2, hh); f.tq = tq;
        QuadStream st; st.setup(PROJ + (size_t)b * SEQ * NINP + C_SLCK + g * 64, (size_t)NINP * 2, VTB + vtb_off(b, 7 + g, 0), lane, wi);
        zero_ot<2>(o); float m = NEG_BIG, l = 0.f;
        SlcIt it; it.um = um; it.pend = -1; it.tmax = tmax; SlcPre pre{f, mask, t0};
        quad_stream(qf, st, ring, f, it, it, pre, n_own, n_own > n_oth ? n_own : n_oth, hh, o, m, l);
        l = half_sum(l); const float g1 = sigmoidf_(bf2f(PROJ[NSA_ROW() * NINP + C_GATE + hd * 3 + 1])); const float w = l > 0.f ? g1 / l : 0.f;
#pragma unroll
        for (int dt = 0; dt < 2; ++dt)
#pragma unroll
            for (int r = 0; r < 16; r += 2) res[dt * 8 + (r >> 1)] = cvtpk(o[dt][r] * w, o[dt][r + 1] * w);
    }
    {
        WinBias f; f.setup(slope2, hh); f.tq = tq; f.t0 = t0;
        QuadStream st; st.setup(PROJ + (size_t)b * SEQ * NINP + C_WINK + g * 64, (size_t)NINP * 2, VTB + vtb_off(b, 9 + g, 0), lane, wi);
        zero_ot<2>(o); float m = NEG_BIG, l = 0.f;
        RangeIt it; it.kt = qt; it.kt0 = t0 >= 512 ? (t0 - 512) >> 5 : 0; RangePre<WinBias> pre{f};
        const int n_own = win_tiles(qt), n_oth = win_tiles(qto);
        quad_stream(qf, st, ring, f, it, it, pre, n_own, n_own > n_oth ? n_own : n_oth, hh, o, m, l);
        l = half_sum(l); const float g2 = sigmoidf_(bf2f(PROJ[NSA_ROW() * NINP + C_GATE + hd * 3 + 2])); const float w = l > 0.f ? g2 / l : 0.f;
#pragma unroll
        for (int dt = 0; dt < 2; ++dt)
#pragma unroll
            for (int r = 0; r < 16; r += 2) { const unsigned pr = res[dt * 8 + (r >> 1)]; res[dt * 8 + (r >> 1)] = cvtpk(fmaf(o[dt][r], w, lo16(pr)), fmaf(o[dt][r + 1], w, hi16(pr))); }
    }
    {
        CmpBias f; f.setup(16.f * slope2, hh); f.tq = tq; f.ncv = tq >= 31 ? ((tq - 31) >> 4) + 1 : 0; f.ncv = f.ncv > 255 ? 255 : f.ncv;
        f.ncv_min = t0 >= 31 ? ((t0 - 31) >> 4) + 1 : 0; f.ncv_min = f.ncv_min > 255 ? 255 : f.ncv_min;
        QuadStream st; st.setup(KC + (size_t)((0 * BATCH + b) * 2 + g) * 256 * 64, 128, VCB + (size_t)(b * 2 + g) * 8 * 4096, lane, wi);
        zero_ot<2>(o); float m = NEG_BIG, l = 0.f;
        const int n_own = cmp_tiles(qt), n_oth = cmp_tiles(qto);
        RangeIt it; it.kt = n_own - 1; it.kt0 = 0; RangePre<CmpBias> pre{f};
        quad_stream(qf, st, ring, f, it, it, pre, n_own, n_own > n_oth ? n_own : n_oth, hh, o, m, l);
        l = half_sum(l); const float g0 = sigmoidf_(bf2f(PROJ[NSA_ROW() * NINP + C_GATE + hd * 3 + 0])); const float w = l > 0.f ? g0 / l : 0.f;
#pragma unroll
        for (int dt = 0; dt < 2; ++dt)
#pragma unroll
            for (int r = 0; r < 16; r += 2) { const unsigned pr = res[dt * 8 + (r >> 1)]; o[dt][r] = fmaf(o[dt][r], w, lo16(pr)); o[dt][r + 1] = fmaf(o[dt][r + 1], w, hi16(pr)); }
    }
    store_ot<2>(O + NSA_ROW() * DM + O_NSA + hd * 64, o, 1.f, fresh_lane() >> 5);
#undef NSA_ROW
    asm volatile("s_waitcnt vmcnt(0) lgkmcnt(0)" ::: "memory"); __builtin_amdgcn_s_barrier(); asm volatile("" ::: "memory");
}
__device__ __forceinline__ void dil_item_mfma(const bf16* PROJ, const unsigned char* VTB, bf16* O, LAS unsigned char* ring  , int bj, int r16, int qt8, int lane) {
    lane = fresh_lane();
    const int b = bj / 3, j = bj % 3, q = lane & 31, hh = lane >> 5, i16 = qt8 * 32 + q, tq = r16 + 16 * i16; const size_t row = (size_t)b * SEQ + tq;
    f32x16 o[3][2]; float m[3], l[3];
#pragma unroll
    for (int g = 0; g < 3; ++g) { const int head = 3 * g + j, d = g == 0 ? 1 : (g == 1 ? 4 : 16), seg = SEQ / d, rd = r16 % d;
        DilBias f; f.setup(exp2f(-8.f * (float)(head + 1) / 9.f) * LOG2E * (float)d, hh); f.iq = tq / d;
        const int imin = (r16 + 16 * (qt8 * 32)) / d, imax = (r16 + 16 * (qt8 * 32 + 31)) / d;
        const int kt0 = imin >= 128 ? (imin - 128) >> 5 : 0, kt1 = imax >> 5;
        bf16x8 qf[4]; load_qfrag(PROJ + row * NINP + C_DILQ + head * 64 + 8 * hh, qf);
        WvStream st; st.setup(PROJ + ((size_t)b * SEQ + rd) * NINP + C_DILK + head * 64, (size_t)d * NINP * 2, VTB + vtb_off(b, 11 + head, rd * (seg >> 5)), lane);
        zero_ot<2>(o[g]); m[g] = NEG_BIG; l[g] = 0.f;
        RangeIt it; it.kt = kt1; it.kt0 = kt0; RangePre<DilBias> pre{f};
        att_stream<2>(qf, st, ring, f, it, pre, hh, o[g], m[g], l[g]);
        l[g] = half_sum(l[g]);
    }
    const float mx = fmaxf(m[0], fmaxf(m[1], m[2]));
    const float e0 = __builtin_amdgcn_exp2f(m[0] - mx), e1 = __builtin_amdgcn_exp2f(m[1] - mx), e2 = __builtin_amdgcn_exp2f(m[2] - mx);
    const float inv = 1.f / (l[0] * e0 + l[1] * e1 + l[2] * e2);
    store_ot<2>(O + row * DM + O_DIL + (0 + j) * 64, o[0], e0 * inv, hh);
    store_ot<2>(O + row * DM + O_DIL + (3 + j) * 64, o[1], e1 * inv, hh);
    store_ot<2>(O + row * DM + O_DIL + (6 + j) * 64, o[2], e2 * inv, hh);
}
__device__ __forceinline__ void compress_item_mfma(const bf16* PROJ, const bf16* W1T, const bf16* W2T, const float* PW1, bf16* KC, unsigned char* VCB, int it, LAS unsigned char* lds, int wave, int lane) {
    const int kv = it >> 5, b = (it >> 4) & 1, g = (it >> 3) & 1, ct = it & 7, cl = lane & 31, hh = lane >> 5;
    const int colbase = (kv ? C_CMPV : C_CMPK) + g * 64, tokbase = 16 * (32 * ct + cl);
    const bf16* w1t = W1T + (size_t)kv * 64 * 2048 + (size_t)cl * 2048 + 8 * hh;
    f32x16 hT[2]; zero_ot<2>(hT);
#pragma unroll 8
    for (int s = 16 * wave; s < 16 * wave + 16; ++s) { int tok = tokbase + (s >> 2); tok = tok < SEQ ? tok : SEQ - 1;
        const bf16x8 bfr = *(const GAS bf16x8*)(PROJ + ((size_t)b * SEQ + tok) * NINP + colbase + 16 * (s & 3) + 8 * hh);
        const bf16x8 a0 = *(const GAS bf16x8*)(w1t + 16 * s), a1 = *(const GAS bf16x8*)(w1t + (size_t)32 * 2048 + 16 * s);
        hT[0] = MFMA32(a0, bfr, hT[0]); hT[1] = MFMA32(a1, bfr, hT[1]); }
    v4u w2f[2][2][2];
    if (wave == 0) {
#pragma unroll
        for (int n2t = 0; n2t < 2; ++n2t)
#pragma unroll
            for (int nt = 0; nt < 2; ++nt)
#pragma unroll
                for (int s2 = 0; s2 < 2; ++s2) { const bf16* wp = W2T + (size_t)kv * 64 * 64 + (size_t)(32 * n2t + cl) * 64 + 32 * nt + 16 * s2 + 4 * hh;
                    const v2u lo = *(const GAS v2u*)wp, hi = *(const GAS v2u*)(wp + 8); v4u a; a.x = lo.x; a.y = lo.y; a.z = hi.x; a.w = hi.y; w2f[n2t][nt][s2] = a; } }
    LAS float* part = (LAS float*)lds;
#pragma unroll
    for (int nt = 0; nt < 2; ++nt)
#pragma unroll
        for (int r = 0; r < 16; ++r) part[(wave * 32 + nt * 16 + r) * 64 + lane] = hT[nt][r];
    __syncthreads();
    if (wave == 0) {
#pragma unroll 1
        for (int w = 1; w < 8; ++w) { const LAS float* pw = part + (size_t)(w * 32) * 64 + lane;
#pragma unroll
            for (int nt = 0; nt < 2; ++nt)
#pragma unroll
                for (int r = 0; r < 16; ++r) hT[nt][r] += pw[(nt * 16 + r) * 64]; }
        bf16x8 xf[2][2];
#pragma unroll
        for (int nt = 0; nt < 2; ++nt) {
#pragma unroll
            for (int g4 = 0; g4 < 4; ++g4) { const f32x4 pb = *(const f32x4*)(PW1 + kv * 64 + 32 * nt + 8 * g4 + 4 * hh);
                hT[nt][4 * g4] = gelu_tanh(hT[nt][4 * g4] + pb.x); hT[nt][4 * g4 + 1] = gelu_tanh(hT[nt][4 * g4 + 1] + pb.y); hT[nt][4 * g4 + 2] = gelu_tanh(hT[nt][4 * g4 + 2] + pb.z); hT[nt][4 * g4 + 3] = gelu_tanh(hT[nt][4 * g4 + 3] + pb.w); }
#pragma unroll
            for (int s2 = 0; s2 < 2; ++s2) { v4u p; p.x = cvtpk(hT[nt][8 * s2], hT[nt][8 * s2 + 1]); p.y = cvtpk(hT[nt][8 * s2 + 2], hT[nt][8 * s2 + 3]); p.z = cvtpk(hT[nt][8 * s2 + 4], hT[nt][8 * s2 + 5]); p.w = cvtpk(hT[nt][8 * s2 + 6], hT[nt][8 * s2 + 7]);
                xf[nt][s2] = __builtin_bit_cast(bf16x8, p); } }
        f32x16 oT[2]; zero_ot<2>(oT);
#pragma unroll
        for (int n2t = 0; n2t < 2; ++n2t)
#pragma unroll
            for (int nt = 0; nt < 2; ++nt)
#pragma unroll
                for (int s2 = 0; s2 < 2; ++s2) oT[n2t] = MFMA32(__builtin_bit_cast(bf16x8, w2f[n2t][nt][s2]), xf[nt][s2], oT[n2t]);
        if (kv == 0) store_ot<2>(KC + ((size_t)((0 * BATCH + b) * 2 + g) * 256 + 32 * ct + cl) * 64, oT, 1.f, hh);
        else { bf16* vb = (bf16*)(VCB + (size_t)((b * 2 + g) * 8 + ct) * 4096) + vtb_pos_of_key(cl);
#pragma unroll
            for (int n2t = 0; n2t < 2; ++n2t)
#pragma unroll
                for (int r = 0; r < 16; ++r) vb[n2t * 1024 + ((r & 3) + 8 * (r >> 2) + 4 * hh) * 32] = (bf16)(cvtpk(oT[n2t][r], 0.f) & 0xffffu); }
    }
    __syncthreads();
}
__device__ __forceinline__ void pre_attn(const bf16* PROJ, const float* fbias, unsigned char* ws, int layer, LAS unsigned char* lds, int bid, int G, int gw, int NGW, int wave, int lane) {
    const int bstride = G >= 64 ? G / 64 : 1;
    for (int it = bid / bstride; it < 64 && bid % bstride == 0; it += G / bstride)
        compress_item_mfma(PROJ, (const bf16*)(ws + WS_W1T) + (size_t)layer * 2 * 64 * 2048, (const bf16*)(ws + WS_W2T) + (size_t)layer * 2 * 64 * 64, (const float*)(ws + WS_PW1) + layer * 2 * 64,
                           (bf16*)(ws + WS_KC), ws + WS_VCB, it, lds, wave, lane);
    for (int ci = (bid - 1) / bstride; ci < BATCH * 7 && bid >= 1 && (bid - 1) % bstride == 0; ci += G / bstride)
        fox_cum_block(PROJ, fbias, (float*)(ws + WS_CUM), ci, lds, wave, lane);
    if (bstride == 4 && G % 4 == 0 && G >= 64) { const bool cum = bid % 4 == 1 && (bid - 1) / 4 < BATCH * 7;
        if (bid % 4 != 0 && !cum) { int ncum = (bid + 2) / 4; ncum = ncum > BATCH * 7 ? BATCH * 7 : ncum;
            const int idx = (bid / 4) * 3 + (bid % 4 - 1) - ncum, nw = (G - G / 4 - BATCH * 7) * NWAVES;
            for (int it = idx * NWAVES + wave; it < BATCH * NHS * VTB_KB; it += nw) vprep_item(PROJ, ws + WS_VTB, it, (LAS unsigned*)(lds + wave * 16384), lane); } }
    else for (int it = gw; it < BATCH * NHS * VTB_KB; it += NGW) vprep_item(PROJ, ws + WS_VTB, it, (LAS unsigned*)(lds + wave * 16384), lane);
}
__device__ __forceinline__ void qk_tile(const bf16x8 (&qf)[4], const bf16* kp, f32x16& s) {
#pragma unroll
    for (int r = 0; r < 16; ++r) s[r] = 0.f;
#pragma unroll
    for (int ks = 0; ks < 4; ++ks) { const bf16x8 kf = *(const bf16x8*)(kp + 16 * ks); s = MFMA32(kf, qf[ks], s); }
}
__device__ __forceinline__ void nsa_select_mfma(const bf16* PROJ, const bf16* KC, unsigned long long* SEL, LAS unsigned* scr  , int it, int lane) {
    const int b = it >> 8, g = (it >> 7) & 1, qt = it & 127, q = lane & 31, hh = lane >> 5, t0 = qt * 32, tq = t0 + q, tmax = t0 + 31; const size_t row = (size_t)b * SEQ + tq;
    int ncv = tq >= 31 ? ((tq - 31) >> 4) + 1 : 0; ncv = ncv > 255 ? 255 : ncv;
    int ncm = tmax >= 31 ? ((tmax - 31) >> 4) + 1 : 0; ncm = ncm > 255 ? 255 : ncm;
    const int ntile = (ncm + 31) >> 5;
    const bf16* kb = KC + ((size_t)((0 * BATCH + b) * 2 + g) * 256 + q) * 64 + 8 * hh;
    const bf16* qb = PROJ + row * NINP + C_NSAQ + (4 * g) * 64 + 8 * hh;
    float mh[4], ih[4];
#pragma unroll
    for (int jh = 0; jh < 4; ++jh) { CmpSel f; f.slope2 = exp2f(-(float)(4 * g + jh + 1)) * LOG2E; f.tq = tq; f.ncv = ncv;
        bf16x8 qf[4]; load_qfrag(qb + jh * 64, qf);
        float m = NEG_BIG, l = 0.f;
#pragma unroll 1
        for (int T = 0; T < ntile; ++T) { f32x16 s; qk_tile(qf, kb + (size_t)(32 * T) * 64, s);
            float mx = NEG_BIG;
#pragma unroll
            for (int r = 0; r < 16; ++r) { s[r] = f(s[r], 32 * T + (r & 3) + 8 * (r >> 2) + 4 * hh, r); mx = fmaxf(mx, s[r]); }
            mx = half_max(mx);
            const float mn = fmaxf(m, mx); float ps = 0.f;
#pragma unroll
            for (int r = 0; r < 16; ++r) ps += __builtin_amdgcn_exp2f(s[r] - mn);
            l = fmaf(l, __builtin_amdgcn_exp2f(m - mn), ps); m = mn; }
        l = half_sum(l);
        mh[jh] = m; ih[jh] = (ncv > 0 && l > 0.f) ? 1.f / l : 0.f;
        asm volatile("" ::: "memory"); }
    const int cur = tq >> 6; float carry = 0.f;
    LAS unsigned* kq = scr + q * 65;
#pragma unroll 1
    for (int T = 0; T < 8; ++T) { f32x16 acc;
#pragma unroll
        for (int r = 0; r < 16; ++r) acc[r] = 0.f;
        if (T < ntile) {
#pragma unroll
            for (int jh = 0; jh < 4; ++jh) { CmpSel f; f.slope2 = exp2f(-(float)(4 * g + jh + 1)) * LOG2E; f.tq = tq; f.ncv = ncv;
                bf16x8 qf[4]; load_qfrag(qb + jh * 64, qf); f32x16 s; qk_tile(qf, kb + (size_t)(32 * T) * 64, s);
#pragma unroll
                for (int r = 0; r < 16; ++r) acc[r] = fmaf(__builtin_amdgcn_exp2f(f(s[r], 32 * T + (r & 3) + 8 * (r >> 2) + 4 * hh, r) - mh[jh]), ih[jh], acc[r]);
                asm volatile("" ::: "memory"); } }
        float x3[4];
#pragma unroll
        for (int g4 = 0; g4 < 4; ++g4) x3[g4] = half_other(acc[4 * g4 + 3], hh);
#pragma unroll
        for (int g4 = 0; g4 < 4; ++g4) { const int idx = 4 * T + g4, j = 2 * idx + hh;
            const float prev3 = hh ? x3[g4] : (g4 > 0 ? x3[g4 - 1] : carry);
            const float imp = prev3 + 2.f * (acc[4 * g4] + acc[4 * g4 + 1] + acc[4 * g4 + 2]) + acc[4 * g4 + 3];
            const bool causal = 64 * j <= tq, forced = j == 0 || j == cur || j == cur - 1;
            const float scv = causal ? (forced ? 1e4f : imp) : 0.f;
            kq[j] = (__builtin_bit_cast(unsigned, scv) & ~63u) | (unsigned)(63 - j); }
        carry = x3[3]; }
    LDS_WAIT(); asm volatile("" ::: "memory");
    unsigned key[32];
#pragma unroll
    for (int idx = 0; idx < 32; ++idx) key[idx] = kq[2 * idx + hh];
    int rank[32];
#pragma unroll
    for (int idx = 0; idx < 32; ++idx) rank[idx] = 0;
#pragma unroll 2
    for (int jj = 0; jj < 64; ++jj) { const unsigned kv = kq[jj];
#pragma unroll
        for (int idx = 0; idx < 32; ++idx) rank[idx] += kv > key[idx] ? 1 : 0; }
    LDS_WAIT(); asm volatile("" ::: "memory");
    unsigned mlo = 0u, mhi = 0u;
#pragma unroll
    for (int idx = 0; idx < 32; ++idx) { const bool sel = rank[idx] < 16 && 64 * (2 * idx + hh) <= tq;
        const unsigned bit = sel ? (1u << ((2 * idx) & 31)) << hh : 0u;
        if (idx < 16) mlo |= bit; else mhi |= bit; }
    mlo = half_or(mlo); mhi = half_or(mhi);
    if (hh == 0) SEL[(size_t)(b * 2 + g) * SEQ + tq] = (unsigned long long)mlo | ((unsigned long long)mhi << 32);
}
__device__ __forceinline__ void qk_tile_lds(const bf16x8 (&qf)[4], const LAS unsigned char* kt, int fk, f32x16& s) {
    bf16x8 kf[4];
#pragma unroll
    for (int ks = 0; ks < 4; ++ks) kf[ks] = *(const LAS bf16x8*)(kt + (fk ^ (ks << 5)));
#pragma unroll
    for (int r = 0; r < 16; ++r) s[r] = 0.f;
#pragma unroll
    for (int ks = 0; ks < 4; ++ks) s = MFMA32(kf[ks], qf[ks], s);
}
__device__ __forceinline__ void nsa_select_coop(const bf16* PROJ, const bf16* KC, unsigned long long* SEL, LAS unsigned char* lds, int pair, int tid) {
    const int wave = tid >> 6, lane = tid & 63, sub = wave >> 2, jh = wave & 3, it = 2 * pair + sub;
    const int b = it >> 8, g = (it >> 7) & 1, qt = it & 127, q = lane & 31, hh = lane >> 5, t0 = qt * 32, tq = t0 + q, tmax = t0 + 31; const size_t row = (size_t)b * SEQ + tq;
    int ncv = tq >= 31 ? ((tq - 31) >> 4) + 1 : 0; ncv = ncv > 255 ? 255 : ncv;
    int ncm = tmax >= 31 ? ((tmax - 31) >> 4) + 1 : 0; ncm = ncm > 255 ? 255 : ncm;
    const int ntile = (ncm + 31) >> 5;
    LAS float* impb = (LAS float*)(lds + sub * 49152);
    LAS unsigned* kq = (LAS unsigned*)(lds + sub * 49152 + 33280) + q * 65;
    LAS unsigned* mk = (LAS unsigned*)(lds + sub * 49152 + 41600) + q * 2;
    LAS unsigned char* kl = lds + 98304;
    {   const int tmx = 32 * ((2 * pair + 1) & 127) + 31; int nc = tmx >= 31 ? ((tmx - 31) >> 4) + 1 : 0; nc = nc > 255 ? 255 : nc; const int nrow = 32 * ((nc + 31) >> 5);
        const GAS v4u* src = (const GAS v4u*)(KC + (size_t)((0 * BATCH + b) * 2 + g) * 256 * 64);
        for (int i = tid; i < nrow * 8; i += NWAVES * 64) { const int rw = i >> 3, c = i & 7; *(LAS v4u*)(kl + rw * 128 + ((c ^ ((rw >> 1) & 7)) << 4)) = src[i]; } }
    const int fk = q * 128 + ((hh ^ ((q >> 1) & 7)) << 4);
    CmpSel f; f.slope2 = exp2f(-(float)(4 * g + jh + 1)) * LOG2E; f.tq = tq; f.ncv = ncv;
    bf16x8 qf[4]; load_qfrag(PROJ + row * NINP + C_NSAQ + (4 * g + jh) * 64 + 8 * hh, qf);
    __syncthreads();
    float m = NEG_BIG, l = 0.f;
#pragma unroll 1
    for (int T = 0; T < ntile; ++T) { f32x16 s; qk_tile_lds(qf, kl + T * 4096, fk, s);
        float mx = NEG_BIG;
#pragma unroll
        for (int r = 0; r < 16; ++r) { s[r] = f(s[r], 32 * T + (r & 3) + 8 * (r >> 2) + 4 * hh, r); mx = fmaxf(mx, s[r]); }
        mx = half_max(mx);
        const float mn = fmaxf(m, mx); float ps = 0.f;
#pragma unroll
        for (int r = 0; r < 16; ++r) ps += __builtin_amdgcn_exp2f(s[r] - mn);
        l = fmaf(l, __builtin_amdgcn_exp2f(m - mn), ps); m = mn; }
    l = half_sum(l);
    const float inv = (ncv > 0 && l > 0.f) ? 1.f / l : 0.f;
    if (lane < 32 && jh == 0) { unsigned z = 0u; asm volatile("" : "+v"(z)); mk[0] = z; mk[1] = z; }
    float carry = 0.f;
    LAS float* ib = impb + (jh * 32 + q) * 65;
#pragma unroll 1
    for (int T = 0; T < 8; ++T) { f32x16 acc;
#pragma unroll
        for (int r = 0; r < 16; ++r) acc[r] = 0.f;
        if (T < ntile) { f32x16 s; qk_tile_lds(qf, kl + T * 4096, fk, s);
#pragma unroll
            for (int r = 0; r < 16; ++r) acc[r] = __builtin_amdgcn_exp2f(f(s[r], 32 * T + (r & 3) + 8 * (r >> 2) + 4 * hh, r) - m) * inv; }
        float x3[4];
#pragma unroll
        for (int g4 = 0; g4 < 4; ++g4) x3[g4] = half_other(acc[4 * g4 + 3], hh);
#pragma unroll
        for (int g4 = 0; g4 < 4; ++g4) { const int j = 2 * (4 * T + g4) + hh;
            const float prev3 = hh ? x3[g4] : (g4 > 0 ? x3[g4 - 1] : carry);
            ib[j] = prev3 + 2.f * (acc[4 * g4] + acc[4 * g4 + 1] + acc[4 * g4 + 2]) + acc[4 * g4 + 3]; }
        carry = x3[3]; }
    __syncthreads();
    const int cur = tq >> 6;
#pragma unroll
    for (int i = 0; i < 8; ++i) { const int j = 2 * (8 * jh + i) + hh; const LAS float* p = impb + q * 65 + j;
        const float imp = ((p[0] + p[32 * 65]) + p[2 * 32 * 65]) + p[3 * 32 * 65];
        const bool causal = 64 * j <= tq, forced = j == 0 || j == cur || j == cur - 1;
        const float scv = causal ? (forced ? 1e4f : imp) : 0.f;
        kq[j] = (__builtin_bit_cast(unsigned, scv) & ~63u) | (unsigned)(63 - j); }
    __syncthreads();
    unsigned key[8]; int rank[8];
#pragma unroll
    for (int i = 0; i < 8; ++i) { key[i] = kq[2 * (8 * jh + i) + hh]; rank[i] = 0; }
#pragma unroll 4
    for (int jj = 0; jj < 64; ++jj) { const unsigned kv = kq[jj];
#pragma unroll
        for (int i = 0; i < 8; ++i) rank[i] += kv > key[i] ? 1 : 0; }
    unsigned bits = 0u;
#pragma unroll
    for (int i = 0; i < 8; ++i) { const int j = 2 * (8 * jh + i) + hh; if (rank[i] < 16 && 64 * j <= tq) bits |= 1u << (j & 31); }
    if (bits) __hip_atomic_fetch_or(mk + (jh >> 1), bits, __ATOMIC_RELAXED, __HIP_MEMORY_SCOPE_WORKGROUP);
    __syncthreads();
    if (jh == 0 && hh == 0) SEL[(size_t)(b * 2 + g) * SEQ + tq] = (unsigned long long)mk[0] | ((unsigned long long)mk[1] << 32);
    __syncthreads();
}
template <int NDT, class F>
__device__ __forceinline__ void coop_step(const bf16x8 (&qf)[4], const LAS unsigned char* buf, int fk, int fv, int vsub  , F& f, int st, int t0_mine, int hh, f32x16 (&o)[NDT], float& m, float& l) {
    const int k0 = 64 * st, k1 = k0 + 32;
    if (k0 > t0_mine) return;
    bf16x8 pf0, pf1;
    if (k1 <= t0_mine) {
        f32x16 sA, sB;
#pragma unroll
        for (int ks = 0; ks < 4; ++ks) { const bf16x8 kf = *(const LAS bf16x8*)(buf + 4096 + (fk ^ (ks << 5))); sA = MFMA32(kf, qf[ks], ks == 0 ? f.c1() : sA); }
        if (NDT == 2) {
#pragma unroll
            for (int ks = 0; ks < 4; ++ks) { const bf16x8 kf = *(const LAS bf16x8*)(buf + (fk ^ (ks << 5))); sB = MFMA32(kf, qf[ks], ks == 0 ? f.c0() : sB); }
            if (st > 0) f.fetch2(st - 1);
            __builtin_amdgcn_sched_barrier(0); }
        f.begin(k1); softmax_body<NDT>(sA, f, k1, hh, o, m, l, pf0, pf1, k1 == t0_mine ? 1 : 0);
#pragma unroll
        for (int dt = 0; dt < NDT; ++dt) { const bf16x8 vf0 = *(const LAS bf16x8*)(buf + 4096 + dt * 2048 + fv + vsub), vf1 = *(const LAS bf16x8*)(buf + 4096 + dt * 2048 + ((fv + vsub) ^ 32));
            o[dt] = MFMA32(vf0, pf0, o[dt]); o[dt] = MFMA32(vf1, pf1, o[dt]); }
        if (NDT != 2) {
#pragma unroll
            for (int ks = 0; ks < 4; ++ks) { const bf16x8 kf = *(const LAS bf16x8*)(buf + (fk ^ (ks << 5))); sB = MFMA32(kf, qf[ks], ks == 0 ? f.c0() : sB); }
            if (st > 0) f.fetch2(st - 1); }
        f.begin(k0); softmax_body<NDT>(sB, f, k0, hh, o, m, l, pf0, pf1, 0);
#pragma unroll
        for (int dt = 0; dt < NDT; ++dt) { const bf16x8 vf0 = *(const LAS bf16x8*)(buf + dt * 2048 + fv), vf1 = *(const LAS bf16x8*)(buf + dt * 2048 + (fv ^ 32));
            o[dt] = MFMA32(vf0, pf0, o[dt]); o[dt] = MFMA32(vf1, pf1, o[dt]); }
    } else {
        f32x16 sB;
#pragma unroll
        for (int ks = 0; ks < 4; ++ks) { const bf16x8 kf = *(const LAS bf16x8*)(buf + (fk ^ (ks << 5))); sB = MFMA32(kf, qf[ks], ks == 0 ? f.c0() : sB); }
        if (st > 0) f.fetch2(st - 1);
        f.begin(k0); softmax_body<NDT>(sB, f, k0, hh, o, m, l, pf0, pf1, 1);
#pragma unroll
        for (int dt = 0; dt < NDT; ++dt) { const bf16x8 vf0 = *(const LAS bf16x8*)(buf + dt * 2048 + fv), vf1 = *(const LAS bf16x8*)(buf + dt * 2048 + (fv ^ 32));
            o[dt] = MFMA32(vf0, pf0, o[dt]); o[dt] = MFMA32(vf1, pf1, o[dt]); }
    }
}
template <int NDT, int NMAP> struct CoopGeom { static constexpr int KB = NMAP * 8192, VS = NDT * 2048, TB = KB + 2 * VS; };
template <int NDT, int NMAP, class F>
__device__ __forceinline__ void coop_pass(const bf16x8 (&qf)[4], const bf16* kcol0, const bf16* kcol1, const unsigned char* vtb0, const unsigned char* vtb1, F& f, int step_last, int t0_mine, int mapsel,
                                          LAS unsigned char* sbuf, int tid, int hh, f32x16 (&o)[NDT], float& m, float& l) {
    typedef CoopGeom<NDT, NMAP> Gm;
    const int lane = tid & 63;
    const int skey = tid >> 3, sch = tid & 7;
    const size_t ksoff = (size_t)skey * NINP + sch * 8;
    const int kdst = skey * 128 + ((sch ^ ((skey >> 1) & 7)) << 4);
    const int w8 = tid * 16;
    const unsigned char* vsrc = (NDT == 4 ? ((w8 >= 4096 ? vtb1 : vtb0) + (w8 & 4095)) : (vtb0 + (size_t)(w8 >> 12) * 4096 + (w8 & 4095)));
    const int vdst = Gm::KB + (NDT == 4 ? ((w8 & 4096) + swz_v(w8 & 4095)) : ((w8 >> 12) * Gm::VS + swz_v(w8 & 4095)));
    const int fk = mapsel * 8192 + (lane & 31) * 128 + ((hh ^ (((lane & 31) >> 1) & 7)) << 4);
    const int fv = Gm::KB + (lane & 31) * 64 + ((hh ^ (((lane & 31) >> 2) & 3)) << 4);
    v4u kr0[2], kr1[2], vr0[2], vr1[2];
#define CP_LOAD(S, st_) do { const size_t ko = ksoff + (size_t)(64 * (st_)) * NINP; const size_t vo = (size_t)(2 * (st_)) * 4096; \
        kr0[S] = *(const GAS v4u*)(kcol0 + ko); if (NMAP == 2) kr1[S] = *(const GAS v4u*)(kcol1 + ko); \
        vr0[S] = *(const GAS v4u*)(vsrc + vo); if (NDT == 4) vr1[S] = *(const GAS v4u*)(vsrc + vo + 4096); } while (0)
#define CP_PARK(S, buf) do { *(LAS v4u*)((buf) + kdst) = kr0[S]; if (NMAP == 2) *(LAS v4u*)((buf) + 8192 + kdst) = kr1[S]; \
        *(LAS v4u*)((buf) + vdst) = vr0[S]; if (NDT == 4) *(LAS v4u*)((buf) + vdst + Gm::VS) = vr1[S]; } while (0)
#define CP_COMPUTE(st_, buf) do { if constexpr (NDT == 2) coop_step<NDT>(qf, (buf), fk, fv, Gm::VS - 4096, f, (st_), t0u, hh, o, m, l); else { \
        _Pragma("unroll") for (int sub = 1; sub >= 0; --sub) { const int k0 = 64 * (st_) + 32 * sub; \
        if (k0 <= t0_mine) { f.begin(k0); \
            if (k0 == t0_mine) att_compute_lds<NDT, true>(qf, (buf) + sub * 4096, fk, fv + sub * (Gm::VS - 4096), f, k0, hh, o, m, l); \
            else att_compute_lds<NDT, false>(qf, (buf) + sub * 4096, fk, fv + sub * (Gm::VS - 4096), f, k0, hh, o, m, l); } } } } while (0)
#define CP_BAR() do { asm volatile("s_waitcnt lgkmcnt(0)" ::: "memory"); __builtin_amdgcn_s_barrier(); asm volatile("" ::: "memory"); } while (0)
    LAS unsigned char* b0 = sbuf; LAS unsigned char* b1 = sbuf + Gm::TB;
    CP_LOAD(0, step_last); if (step_last >= 1) CP_LOAD(1, step_last - 1);
    const int t0u = __builtin_amdgcn_readfirstlane(t0_mine);
    f.fetch2(t0u >> 6);
    CP_PARK(0, b0);
    CP_BAR();
#pragma unroll 1
    for (int st = step_last; st >= 0; st -= 2) {
        if (st - 2 >= 0) CP_LOAD(0, st - 2);
        __builtin_amdgcn_sched_barrier(0);
        CP_COMPUTE(st, b0);
        if (st - 1 >= 0) CP_PARK(1, b1);
        CP_BAR();
        if (st - 1 < 0) break;
        if (st - 3 >= 0) CP_LOAD(1, st - 3);
        __builtin_amdgcn_sched_barrier(0);
        CP_COMPUTE(st - 1, b1);
        if (st - 2 >= 0) CP_PARK(0, b0);
        CP_BAR();
    }
#undef CP_LOAD
#undef CP_PARK
#undef CP_COMPUTE
#undef CP_BAR
    __syncthreads();
}
__device__ __forceinline__ void fox_coop(const bf16* PROJ, const float* CUM, const unsigned char* VTB, bf16* O, int bh, int c, LAS unsigned char* sbuf, int tid) {
    const int wave = tid >> 6, lane = tid & 63, b = bh / 7, hd = bh % 7, q = lane & 31, hh = lane >> 5, qt = 8 * c + wave, tq = 32 * qt + q; const size_t row = (size_t)b * SEQ + tq;
    bf16x8 qf[4]; load_qfrag(PROJ + row * NINP + C_FOXQ + hd * 64 + 8 * hh, qf);
    FoxBias f; f.cum2 = CUM + (size_t)(b * 7 + hd) * SEQ; f.tadd = -QK_SCL * f.cum2[tq]; f.tq = tq; f.t0 = 32 * qt; f.hh = hh;
    f32x16 o[2]; zero_ot<2>(o); float m = NEG_BIG, l = 0.f;
    const bf16* kc = PROJ + (size_t)b * SEQ * NINP + C_FOXK + hd * 64;
    coop_pass<2, 1>(qf, kc, kc, VTB + vtb_off(b, hd, 0), VTB, f, 4 * c + 3, 32 * qt, 0, sbuf, tid, hh, o, m, l);
    l = half_sum(l);
    store_ot<2>(O + row * DM + O_FOX + hd * 64, o, 1.f / l, hh);
}
__device__ __forceinline__ void dif_coop(const bf16* PROJ, const unsigned char* VTB, bf16* O, float lam, const float* subg, float oscale, int bh, int c, LAS unsigned char* sbuf, int tid) {
    const int wave = tid >> 6, lane = tid & 63, b = bh >> 2, hd = bh & 3, q = lane & 31, hh = lane >> 5, mp = wave >> 2, qt = 4 * c + (wave & 3), tq = 32 * qt + q; const size_t row = (size_t)b * SEQ + tq;
    AlibiCausal f; f.setup(exp2f(-2.f * (float)(hd + 1)) * LOG2E, hh); f.tq = tq; f.t0 = 32 * qt;
    bf16x8 qf[4]; load_qfrag(PROJ + row * NINP + C_DIFQ + hd * 128 + mp * 64 + 8 * hh, qf);
    f32x16 o[4]; zero_ot<4>(o); float m = NEG_BIG, l = 0.f;
    const bf16* kc = PROJ + (size_t)b * SEQ * NINP + C_DIFK + hd * 128;
    coop_pass<4, 2>(qf, kc, kc + 64, VTB + vtb_off(b, 20 + 2 * hd, 0), VTB + vtb_off(b, 21 + 2 * hd, 0), f, (4 * c + 3) >> 1, 32 * qt, mp, sbuf, tid, hh, o, m, l);
    l = half_sum(l);
    const float sc = mp ? lam / l : 1.f / l;
    LAS float* xb = (LAS float*)(sbuf + (wave & 3) * 16384) + lane;
    if (mp) {
#pragma unroll
        for (int dt = 0; dt < 4; ++dt)
#pragma unroll
            for (int r = 0; r < 16; ++r) xb[(dt * 16 + r) * 64] = o[dt][r] * sc; }
    __syncthreads();
    if (!mp) { float ss = 0.f;
#pragma unroll
        for (int dt = 0; dt < 4; ++dt)
#pragma unroll
            for (int r = 0; r < 16; ++r) { const float v = o[dt][r] * sc - xb[(dt * 16 + r) * 64]; o[dt][r] = v; ss = fmaf(v, v, ss); }
        ss = half_sum(ss);
        const float rs = rsqrtf(ss * (1.f / 128.f) + 1e-6f) * oscale;
#pragma unroll
        for (int dt = 0; dt < 4; ++dt) {
#pragma unroll
            for (int g = 0; g < 4; ++g) { const f32x4 gg = *(const f32x4*)(subg + 32 * dt + 8 * g + 4 * hh);
                o[dt][4 * g] *= gg.x; o[dt][4 * g + 1] *= gg.y; o[dt][4 * g + 2] *= gg.z; o[dt][4 * g + 3] *= gg.w; }
            asm volatile("" ::: "memory"); }
        store_ot<4>(O + row * DM + O_DIF + hd * 128, o, rs, hh); }
    __syncthreads();
}
struct Args { const float* in[18]; float* out; unsigned char* ws; int ph_lo, ph_hi; };
#define CAS __attribute__((address_space(4)))
__device__ __forceinline__ unsigned long long karg64(int off) { return *(volatile CAS unsigned long long*)((CAS char*)__builtin_amdgcn_kernarg_segment_ptr() + off); }
__device__ __forceinline__ int karg32(int off) { return *(volatile CAS int*)((CAS char*)__builtin_amdgcn_kernarg_segment_ptr() + off); }
#define ARG_IN(i) ((const float*)karg64(8 * (i)))
#define ARG_OUT() ((float*)karg64(8 * 18))
#define ARG_WS() ((unsigned char*)karg64(8 * 19))
static_assert(sizeof(Args) == 8 * 20 + 8, "Args layout");
enum { A_X = 0, A_C, A_ADAW, A_ADAB, A_GMIX, A_GFFN, A_WIN, A_FBIAS, A_W1, A_W2, A_POS, A_LAM, A_SUBG, A_WOUT, A_WGATE, A_WUP, A_WDOWN, A_GFINAL };
#define WSP(T, off) ((T*)(ws + (off)))
constexpr int CW_XQ = 32768;
#define XQ_HEAD(cls, q) ((gu32*)(ARG_WS() + WS_CTL) + CW_XQ + ((((layer) * 5 + (cls)) * 8 + (q)) * 2 + rep) * 16)
#ifndef PROBE_KEEP
#define PROBE_KEEP 31
#endif
#define PK(bit) (rep == 0 || (PROBE_KEEP & (bit)))
template <int ATTM> __device__ __forceinline__ void attention_phase(int layer, int lane, int rep, LAS unsigned char* lds, int wave) {
    asm volatile("" : "+s"(wave));
#define WG_DRAW(cls, q) LAS int* slot = (LAS int*)(lds + MISC_OFF + 64); \
        if (threadIdx.x == 0) *slot = (int)__hip_atomic_fetch_add(XQ_HEAD(cls, q), 1u, RLX_AGENT); \
        __syncthreads(); const int it = *slot; __syncthreads();
    if ((ATTM & 2) && PK(2)) {
#pragma unroll 1
        for (int qq = 0; qq < 8; ++qq) { const int q = ((int)(xb_xcc_id() & 7u) + qq) & 7;
            for (;;) { WG_DRAW(0, q); if (it >= 32) break;
                unsigned char* ws = ARG_WS(); int tid = threadIdx.x; asm volatile("" : "+v"(tid));
                const float* lamv = ARG_IN(A_LAM) + (size_t)layer * 4 * 64;
                const float lam_init = 0.8f - 0.6f * expf(-0.3f * (float)layer);
                const float sa = wave_sum(lamv[lane] * lamv[64 + lane]), sb = wave_sum(lamv[128 + lane] * lamv[192 + lane]);
                const float lam = expf(sa) - expf(sb) + lam_init;
                dif_coop(WSP(bf16, WS_PROJ), ws + WS_VTB, WSP(bf16, WS_O), lam, ARG_IN(A_SUBG) + (size_t)layer * 128, 1.f - lam_init, q, 31 - it, lds, tid); } } }
    if ((ATTM & 1) && PK(1)) {
#pragma unroll 1
        for (int qq = 0; qq < 8; ++qq) { const int q = ((int)(xb_xcc_id() & 7u) + qq) & 7; const int two = q + 8 < BATCH * 7 ? 1 : 0;
            for (;;) { WG_DRAW(1, q); if (it >= (two ? 32 : 16)) break;
                unsigned char* ws = ARG_WS(); int tid = threadIdx.x; asm volatile("" : "+v"(tid));
                const int bh = two ? ((it & 1) ? q + 8 : q) : q, c = 15 - (two ? (it >> 1) : it);
                fox_coop(WSP(bf16, WS_PROJ), WSP(float, WS_CUM), ws + WS_VTB, WSP(bf16, WS_O), bh, c, lds, tid); } } }
    if ((ATTM & 4) && PK(4)) {
#pragma unroll 1
        for (int qq = 0; qq < 8; ++qq) { const int q = ((int)(xb_xcc_id() & 7u) + qq) & 7;
            for (;;) { WG_DRAW(2, q); if (it >= 32) break; unsigned char* ws = ARG_WS();
                nsa_quad_item(WSP(bf16, WS_PROJ), WSP(bf16, WS_KC), ws + WS_VCB, ws + WS_VTB, WSP(unsigned long long, WS_SEL), WSP(bf16, WS_O), lds, q >> 1, 2 * (31 - it) + (q & 1), wave); } } }
#undef WG_DRAW
#define WV_DRAW(cls, q, n) int it = 0; if (__builtin_amdgcn_mbcnt_hi(~0u, __builtin_amdgcn_mbcnt_lo(~0u, 0u)) == 0u) it = (int)__hip_atomic_fetch_add(XQ_HEAD(cls, q), (unsigned)(n), RLX_AGENT); it = __builtin_amdgcn_readfirstlane(it);
    if ((ATTM & 8) && PK(8)) {
#pragma unroll 1
        for (int qq = 0; qq < 8; ++qq) { const int q = ((int)(xb_xcc_id() & 7u) + qq) & 7;
            for (;;) { WV_DRAW(3, q, 1); if (it >= 96) break; unsigned char* ws = ARG_WS();
                const int chunk = 3 * q + it / 32, idx = (chunk & 3) * 32 + (it & 31);
                dil_item_mfma(WSP(bf16, WS_PROJ), ws + WS_VTB, WSP(bf16, WS_O), lds + wave * 16384, chunk >> 2, idx & 15, idx >> 4, lane); } } }
    if (!(ATTM & 32) && PK(16) && layer + 1 < DEPTH) {
#pragma unroll 1
        for (int qq = 0; qq < 8; ++qq) { const int q = ((int)(xb_xcc_id() & 7u) + qq) & 7;
            for (;;) { WV_DRAW(4, q, 4); if (it >= I_LAYER / 8) break; unsigned char* ws = ARG_WS();
#pragma unroll 1
                for (int k = it; k < it + 4 && k < I_LAYER / 8; ++k) conv_item(ARG_IN(A_WIN), ARG_IN(A_WOUT), ARG_IN(A_WGATE), ARG_IN(A_WUP), ARG_IN(A_WDOWN), ws, layer + 1, q * (I_LAYER / 8) + k, lds + wave * 16384, fresh_lane()); } } }
#undef WV_DRAW
}
static_assert(I_LAYER % 8 == 0, "conversion items split evenly over the 8 queues");
template <int PHM, int ATTM> __global__ void __launch_bounds__(NWAVES * 64, 2) fwd_kernel(Args args) {
    extern __shared__ __attribute__((aligned(16))) unsigned char lds_raw[];
    LAS unsigned char* lds = (LAS unsigned char*)lds_raw;
    for (int u = threadIdx.x; u < (LDS_BYTES - LDSCTL_OFF) / 4; u += NWAVES * 64) ((LAS unsigned*)(lds + LDSCTL_OFF))[u] = 0u;
    __syncthreads();
    XcdBarrier bar; bar.bar = nullptr; bar.x = 0; bar.st = nullptr;
    if (N_LAUNCH_MODE == 0) bar = xcd_barrier_post((unsigned*)(ARG_WS() + WS_CTL) + CW_BAR, (volatile LAS unsigned*)(lds + MISC_OFF) + 8);
    const int lo = karg32(8 * 20), hi = karg32(8 * 20 + 4);
#define IN(k) (lo <= (k) && (k) < hi)
#ifndef DUP_PHASE
#define DUP_PHASE -1
#endif
#define REP(k) for (int rep_ = 0; rep_ < (DUP_PHASE == (k) ? 2 : 1); ++rep_, (DUP_PHASE == (k) ? xcd_barrier(bar) : (void)0))
#define IDX() int tid = threadIdx.x, bid = blockIdx.x, G = gridDim.x; asm volatile("" : "+v"(tid)); asm volatile("" : "+s"(bid), "+s"(G)); \
    const int lane = tid & 63, wave = __builtin_amdgcn_readfirstlane(tid >> 6), gw = bid * NWAVES + wave, NGW = G * NWAVES; (void)lane; (void)gw; (void)NGW; (void)wave
#define EN(b) ((PHM >> (b)) & 1)
#define SEAM(k) do { if (N_LAUNCH_MODE == 0 && IN(k) && IN((k) + 1)) xcd_barrier(bar); } while (0)

    REP(0) if (IN(0) && EN(0)) { IDX();
        { unsigned char* ws = ARG_WS(); p0_weights(ARG_IN(A_WIN), ARG_IN(A_WOUT), ARG_IN(A_WGATE), ARG_IN(A_WUP), ARG_IN(A_WDOWN), ws, lds + wave * 16384, gw, NGW, lane); }
        __syncthreads();
        { unsigned char* ws = ARG_WS(); p0_mod(ARG_IN(A_C), ARG_IN(A_ADAW), ARG_IN(A_ADAB), WSP(float, WS_MOD), lds, bid, G, tid, wave, lane); }
        __syncthreads();
        { unsigned char* ws = ARG_WS(); p0_cmpw(ARG_IN(A_W1), ARG_IN(A_W2), ARG_IN(A_POS), ws, lds, gw, NGW, bid, G, wave, lane); }
    }
    SEAM(0);
#pragma unroll 1
    for (int layer = 0; layer < DEPTH; ++layer) {
        const int pb = 1 + layer * NPL;
        REP(1) if (IN(pb + 0) && EN(1)) { IDX(); unsigned char* ws = ARG_WS(); const float* mod = WSP(float, WS_MOD) + (size_t)layer * BATCH * NADA;
            if (layer == 0) norm_mod_rows(ARG_IN(A_X), ARG_IN(A_GMIX) + (size_t)layer * DM, mod + 0, mod + DM, WSP(bf16, WS_U), gw, NGW, lane);
            else norm_mod_rows_b(WSP(bf16, WS_H), ARG_IN(A_GMIX) + (size_t)layer * DM, mod + 0, mod + DM, WSP(bf16, WS_U), gw, NGW, lane); }
        SEAM(pb + 0);
        REP(2) if (IN(pb + 1) && EN(2)) { IDX(); unsigned char* ws = ARG_WS();
            pg8::Gemm g{WSP(bf16, WS_U), WSP(bf16, WS_W + (size_t)layer * W_LAYER + W_IN), M, NINP, DM}; pg8::StaticOrder S; S.init(M, NINP, G, bid);
            pg8::EpiBf16 E{WSP(bf16, WS_PROJ), NINP}; pg8::gemm_phase<pg8::EpiBf16, pg8::StaticOrder, true, true>(lds, g, S, E); }
        SEAM(pb + 1);
        REP(3) if (IN(pb + 2) && EN(3)) { IDX(); unsigned char* ws = ARG_WS();
            pre_attn(WSP(bf16, WS_PROJ), ARG_IN(A_FBIAS) + layer * 7, ws, layer, lds, bid, G, gw, NGW, wave, lane); }
        SEAM(pb + 2);
        REP(4) if (IN(pb + 3) && EN(4)) { IDX(); unsigned char* ws = ARG_WS(); for (int pair = bid; pair < 256; pair += G) nsa_select_coop(WSP(bf16, WS_PROJ), WSP(bf16, WS_KC), WSP(unsigned long long, WS_SEL), lds, pair, tid); }
        SEAM(pb + 3);
        if (IN(pb + 4) && EN(5)) for (int rep = 0; rep < (DUP_PHASE == 5 ? 2 : 1); ++rep, (DUP_PHASE == 5 ? xcd_barrier(bar) : (void)0)) { IDX();
            attention_phase<ATTM>(layer, lane, rep, lds, wave); }
        SEAM(pb + 4);
        REP(6) if (IN(pb + 5) && EN(6)) { IDX(); unsigned char* ws = ARG_WS(); const float* mod = WSP(float, WS_MOD) + (size_t)layer * BATCH * NADA;
            pg8::Gemm g{WSP(bf16, WS_O), WSP(bf16, WS_W + (size_t)layer * W_LAYER + W_OUT), M, DM, DM}; pg8::StaticOrder S; S.init(M, DM, G, bid);
            pg8::EpiResidB E{layer == 0 ? (const void*)ARG_IN(A_X) : (const void*)WSP(bf16, WS_H), rep_ ? WSP(bf16, WS_PROJ) : WSP(bf16, WS_H), DM, mod + 2 * DM, NADA, layer == 0 ? 1 : 0}; pg8::gemm_phase<pg8::EpiResidB, pg8::StaticOrder, false, true>(lds, g, S, E); }
        SEAM(pb + 5);
        if (IN(pb + 6) && EN(7)) { IDX(); unsigned char* ws = ARG_WS(); const float* mod = WSP(float, WS_MOD) + (size_t)layer * BATCH * NADA;
            norm_mod_rows_b(WSP(bf16, WS_H), ARG_IN(A_GFFN) + (size_t)layer * DM, mod + 3 * DM, mod + 4 * DM, WSP(bf16, WS_U), gw, NGW, lane); }
        SEAM(pb + 6);
        REP(8) if (IN(pb + 7) && EN(8)) { IDX(); unsigned char* ws = ARG_WS();
            pg8::Gemm g{WSP(bf16, WS_U), WSP(bf16, WS_W + (size_t)layer * W_LAYER + W_GU), M, NGU, DM}; pg8::StaticOrder S; S.init(M, NGU, G, bid);
            pg8::EpiSwiglu E{WSP(bf16, WS_ACT), DFF}; pg8::gemm_phase<pg8::EpiSwiglu, pg8::StaticOrder, true, true>(lds, g, S, E); }
        SEAM(pb + 7);
        REP(9) if (IN(pb + 8) && EN(9)) { IDX(); unsigned char* ws = ARG_WS(); const float* mod = WSP(float, WS_MOD) + (size_t)layer * BATCH * NADA;
            pg8::Gemm g{WSP(bf16, WS_ACT), WSP(bf16, WS_W + (size_t)layer * W_LAYER + W_D), M, DM, DFF}; pg8::StaticOrder S; S.init(M, DM, G, bid);
            pg8::EpiResidB E{(const void*)WSP(bf16, WS_H), rep_ ? WSP(bf16, WS_PROJ) : WSP(bf16, WS_H), DM, mod + 5 * DM, NADA, 0}; pg8::gemm_phase<pg8::EpiResidB, pg8::StaticOrder, false, true>(lds, g, S, E); }
        SEAM(pb + 8);
    }
    if (IN(NPH - 1) && EN(10)) { IDX(); unsigned char* ws = ARG_WS(); norm_final_rows(WSP(bf16, WS_H), ARG_IN(A_GFINAL), ARG_OUT(), gw, NGW, lane); }
#undef IN
#undef SEAM
}

typedef void (*kern_t)(Args);
#if N_LAUNCH_MODE != 0
static kern_t kern_of(int kind, int am) {
    switch (kind) {
        case 0: return fwd_kernel<1 << 0, 0>; case 1: return fwd_kernel<1 << 1, 0>; case 2: return fwd_kernel<1 << 2, 0>; case 3: return fwd_kernel<1 << 3, 0>; case 4: return fwd_kernel<1 << 4, 0>;
        case 5: return am == 1 ? fwd_kernel<1 << 5, 1> : am == 2 ? fwd_kernel<1 << 5, 2> : am == 4 ? fwd_kernel<1 << 5, 4> : fwd_kernel<1 << 5, 8>;
        case 6: return fwd_kernel<1 << 6, 0>; case 7: return fwd_kernel<1 << 7, 0>; case 8: return fwd_kernel<1 << 8, 0>; case 9: return fwd_kernel<1 << 9, 0>; default: return fwd_kernel<1 << 10, 0>;
    }
}
#endif
extern "C" void kernel_launch(void* const* d_in, const int* in_sizes, int n_in, void* d_out, int out_size, void* d_ws, size_t ws_size, hipStream_t stream) {
    static int grid = 0;
    if (grid == 0) {
        if (n_in != 18 || in_sizes[0] != M * DM || out_size != M * DM || ws_size < WS_END) { fprintf(stderr, "kernel_launch: unexpected shapes (n_in %d, in0 %d, out %d, ws %zu < %zu); nothing launched\n", n_in, n_in > 0 ? in_sizes[0] : -1, out_size, ws_size, (size_t)WS_END); grid = -1; return; }
        int dev = 0, cus = 0;
        if (hipGetDevice(&dev) != hipSuccess || hipDeviceGetAttribute(&cus, hipDeviceAttributeMultiprocessorCount, dev) != hipSuccess) { fprintf(stderr, "kernel_launch: device query failed\n"); grid = -1; return; }
#if N_LAUNCH_MODE == 0
        {
            int per_cu = 0;
            if (hipFuncSetAttribute((const void*)fwd_kernel<0xFFFF, 15>, hipFuncAttributeMaxDynamicSharedMemorySize, LDS_BYTES) != hipSuccess) { fprintf(stderr, "kernel_launch: hipFuncSetAttribute failed\n"); grid = -1; return; }
            if (hipOccupancyMaxActiveBlocksPerMultiprocessor(&per_cu, (const void*)fwd_kernel<0xFFFF, 15>, NWAVES * 64, LDS_BYTES) != hipSuccess || per_cu < 1)
                fprintf(stderr, "kernel_launch: note: occupancy query reports %d workgroups per CU\n", per_cu);
        }
#else
        for (int k = 0; k <= 10; ++k) for (int am = 1; am <= 8; am <<= 1)
            if (hipFuncSetAttribute((const void*)kern_of(k, am), hipFuncAttributeMaxDynamicSharedMemorySize, LDS_BYTES) != hipSuccess) { fprintf(stderr, "kernel_launch: hipFuncSetAttribute failed\n"); grid = -1; return; }
#endif
        (void)hipGetLastError();
        grid = cus;
    }
    if (grid < 0) return;
    if (hipMemsetAsync((char*)d_ws + WS_CTL, 0, CTL_ZERO_BYTES, stream) != hipSuccess) { fprintf(stderr, "kernel_launch: hipMemsetAsync failed\n"); return; }
    Args a{};
    for (int i = 0; i < 18; ++i) a.in[i] = (const float*)d_in[i];
    a.out = (float*)d_out; a.ws = (unsigned char*)d_ws;
#if N_LAUNCH_MODE == 0
    {
        a.ph_lo = 0; a.ph_hi = NPH;
        hipLaunchKernelGGL((fwd_kernel<0xFFFF, 15>), dim3(grid), dim3(NWAVES * 64), LDS_BYTES, stream, a);
        const hipError_t le = hipPeekAtLastError();
        if (le != hipSuccess) fprintf(stderr, "kernel_launch: launch failed: %s\n", hipGetErrorName(le));
    }
#else
    {
        for (int p = 0; p < NPH; ++p) { a.ph_lo = p; a.ph_hi = p + 1;
            const int kind = p == 0 ? 0 : (p == NPH - 1 ? 10 : 1 + (p - 1) % NPL);
            for (int am = 1; am <= (kind == 5 ? 8 : 1); am <<= 1) {
                hipLaunchKernelGGL(kern_of(kind, am), dim3(grid), dim3(NWAVES * 64), LDS_BYTES, stream, a);
                const hipError_t le = hipPeekAtLastError();
                if (le != hipSuccess) { fprintf(stderr, "kernel_launch: launch %d failed: %s\n", p, hipGetErrorName(le)); return; } } }
    }
#endif
}
```

```cpp
#include <hip/hip_runtime.h>
#include <cstdio>
#include <cstdint>
namespace pg8 {
#define PG8_LAS __attribute__((address_space(3)))
typedef unsigned short bf16_t;
typedef short bf16x8 __attribute__((ext_vector_type(8)));
typedef float f32x4 __attribute__((ext_vector_type(4)));
typedef unsigned u32x4 __attribute__((ext_vector_type(4)));
constexpr int BM = 256, BK = 64, HALF = 128, HTB = HALF * BK * 2  , STAGE_BYTES = 8 * HTB, NXCD = 8, WGM = 8;

__host__ __device__ __forceinline__ int lds_byte(int r, int c) { const int st = (r >> 4) * 2 + (c >> 5), rr = r & 15, cc = c & 31, ob = rr * 64 + cc * 2; return st * 1024 + (ob ^ (((ob >> 9) & 1) << 5)); }
__host__ __device__ __forceinline__ void stage_rc(int b, int& R, int& C) { const int st = b / 1024, sb = b % 1024, swz = sb ^ (((sb >> 9) & 1) << 5); R = (st >> 1) * 16 + swz / 64; C = (st & 1) * 32 + (swz % 64) / 2; }
__host__ __device__ __forceinline__ int perm32(int rho) { const int n = rho >> 4, i = rho & 15; return 8 * (i >> 2) + 4 * n + (i & 3); }

struct Unit { int pm, pn; };
struct Gemm { const bf16_t* A; const bf16_t* Bt; int M, N, K; };

struct StaticOrder {
    int nM, nN, nwg, G, c;
    __host__ __device__ void init(int M, int N, int G_, int c_) { nM = M / BM; nN = N / BM; nwg = nM * nN; G = G_; c = c_; }
    __host__ __device__ bool next(int i, Unit& u) const {
        const long L = (long)i * G + c; if (L >= nwg) return false;
        int wgid = (int)L; { const int q = nwg / NXCD, r = nwg % NXCD, xcd = wgid % NXCD, off = wgid / NXCD; wgid = (xcd < r ? xcd * (q + 1) : r * (q + 1) + (xcd - r) * q) + off; }
        const int nig = WGM * nN, gid = wgid / nig, fm = gid * WGM, gsz = (nM - fm) < WGM ? (nM - fm) : WGM;
        u.pm = fm + ((wgid % nig) % gsz); u.pn = (wgid % nig) / gsz; return true;
    }
    __device__ __forceinline__ void a_ready(const Unit&) const {}
    __device__ __forceinline__ void done(const Unit&) const {}
};
__device__ __forceinline__ unsigned cvt_pk_bf16(float lo, float hi) { unsigned r; asm volatile("v_cvt_pk_bf16_f32 %0, %1, %2" : "=v"(r) : "v"(lo), "v"(hi)); return r; }
struct EpiBf16 {
    static constexpr bool PERM = true, AFTER_DRAIN = false;
    bf16_t* O; int ldc;
    __device__ __forceinline__ void operator()(const f32x4 (&acc)[2][2][4][2], const Unit& u, int wr, int wc, int fr, int fq) const {
        const int row0 = u.pm * BM + wr * 64 + fr; const int col0 = u.pn * BM + wc * 32 + 8 * fq;
#pragma unroll
        for (int ai = 0; ai < 2; ++ai)
#pragma unroll
            for (int m = 0; m < 4; ++m) { bf16_t* rowp = O + (size_t)(row0 + ai * HALF + m * 16) * ldc + col0;
#pragma unroll
                for (int bj = 0; bj < 2; ++bj) { const f32x4 v0 = acc[ai][bj][m][0], v1 = acc[ai][bj][m][1];
                    u32x4 w; w.x = cvt_pk_bf16(v0[0], v0[1]); w.y = cvt_pk_bf16(v0[2], v0[3]); w.z = cvt_pk_bf16(v1[0], v1[1]); w.w = cvt_pk_bf16(v1[2], v1[3]);
                    *(u32x4*)(rowp + bj * HALF) = w; } }
    }
};
__device__ __forceinline__ float silu_mul(float g, float u) { return g * __builtin_amdgcn_rcpf(1.0f + __builtin_amdgcn_exp2f(-1.4426950408889634f * g)) * u; }
struct EpiSwiglu {
    static constexpr bool PERM = true, AFTER_DRAIN = false;
    bf16_t* O; int ldc;
    __device__ __forceinline__ void operator()(const f32x4 (&acc)[2][2][4][2], const Unit& u, int wr, int wc, int fr, int fq) const {
        const int row0 = u.pm * BM + wr * 64 + fr; const int col0 = u.pn * HALF + wc * 32 + 8 * fq;
#pragma unroll
        for (int ai = 0; ai < 2; ++ai)
#pragma unroll
            for (int m = 0; m < 4; ++m) { bf16_t* rowp = O + (size_t)(row0 + ai * HALF + m * 16) * ldc + col0;
                const f32x4 g0 = acc[ai][0][m][0], g1 = acc[ai][0][m][1], u0 = acc[ai][1][m][0], u1 = acc[ai][1][m][1];
                u32x4 w; w.x = cvt_pk_bf16(silu_mul(g0[0], u0[0]), silu_mul(g0[1], u0[1])); w.y = cvt_pk_bf16(silu_mul(g0[2], u0[2]), silu_mul(g0[3], u0[3]));
                w.z = cvt_pk_bf16(silu_mul(g1[0], u1[0]), silu_mul(g1[1], u1[1])); w.w = cvt_pk_bf16(silu_mul(g1[2], u1[2]), silu_mul(g1[3], u1[3]));
                *(u32x4*)rowp = w; }
    }
};
struct EpiResid {
    static constexpr bool PERM = false, AFTER_DRAIN = false;
    const float* base; float* out; int ldc; const float* gate; int gstride;
    __device__ __forceinline__ void operator()(const f32x4 (&acc)[2][2][4][2], const Unit& u, int wr, int wc, int fr, int fq) const {
        const int col0 = u.pn * BM + wc * 32 + 4 * fq;
        const float* gp = gate + (size_t)((u.pm * BM) >> 12) * gstride + col0;
        f32x4 gv[2][2];
#pragma unroll
        for (int bj = 0; bj < 2; ++bj)
#pragma unroll
            for (int n = 0; n < 2; ++n) gv[bj][n] = *(const f32x4*)(gp + bj * HALF + n * 16);
#pragma unroll
        for (int ai = 0; ai < 2; ++ai)
#pragma unroll
            for (int m2 = 0; m2 < 2; ++m2) { f32x4 bs[2][2][2];
#pragma unroll
                for (int mm = 0; mm < 2; ++mm) { const size_t off = (size_t)(u.pm * BM + ai * HALF + wr * 64 + (2 * m2 + mm) * 16 + fr) * ldc + col0;
#pragma unroll
                    for (int bj = 0; bj < 2; ++bj)
#pragma unroll
                        for (int n = 0; n < 2; ++n) bs[mm][bj][n] = *(const f32x4*)(base + off + bj * HALF + n * 16); }
#pragma unroll
                for (int mm = 0; mm < 2; ++mm) { const size_t off = (size_t)(u.pm * BM + ai * HALF + wr * 64 + (2 * m2 + mm) * 16 + fr) * ldc + col0;
#pragma unroll
                    for (int bj = 0; bj < 2; ++bj)
#pragma unroll
                        for (int n = 0; n < 2; ++n) *(f32x4*)(out + off + bj * HALF + n * 16) = bs[mm][bj][n] + gv[bj][n] * acc[ai][bj][2 * m2 + mm][n]; }
                asm volatile("" ::: "memory"); }
    }
};

struct EpiResidB {
    static constexpr bool PERM = true, AFTER_DRAIN = false;
    const void* base; bf16_t* out; int ldc; const float* gate; int gstride; int base_f32;
    __device__ __forceinline__ void operator()(const f32x4 (&acc)[2][2][4][2], const Unit& u, int wr, int wc, int fr, int fq) const {
        const int row0 = u.pm * BM + wr * 64 + fr; const int col0 = u.pn * BM + wc * 32 + 8 * fq;
        const float* gp = gate + (size_t)((u.pm * BM) >> 12) * gstride + col0;
        f32x4 gv[2][2];
#pragma unroll
        for (int bj = 0; bj < 2; ++bj)
#pragma unroll
            for (int n = 0; n < 2; ++n) gv[bj][n] = *(const f32x4*)(gp + bj * HALF + n * 4);
        if (base_f32) { const float* bp = (const float*)base;
#pragma unroll
            for (int ai = 0; ai < 2; ++ai)
#pragma unroll
                for (int m2 = 0; m2 < 2; ++m2) { f32x4 bs[2][2][2];
#pragma unroll
                    for (int mm = 0; mm < 2; ++mm) { const size_t off = (size_t)(row0 + ai * HALF + (2 * m2 + mm) * 16) * ldc + col0;
#pragma unroll
                        for (int bj = 0; bj < 2; ++bj)
#pragma unroll
                            for (int n = 0; n < 2; ++n) bs[mm][bj][n] = *(const f32x4*)(bp + off + bj * HALF + n * 4); }
#pragma unroll
                    for (int mm = 0; mm < 2; ++mm) { const size_t off = (size_t)(row0 + ai * HALF + (2 * m2 + mm) * 16) * ldc + col0;
#pragma unroll
                        for (int bj = 0; bj < 2; ++bj) { const f32x4 v0 = bs[mm][bj][0] + gv[bj][0] * acc[ai][bj][2 * m2 + mm][0], v1 = bs[mm][bj][1] + gv[bj][1] * acc[ai][bj][2 * m2 + mm][1];
                            u32x4 w; w.x = cvt_pk_bf16(v0[0], v0[1]); w.y = cvt_pk_bf16(v0[2], v0[3]); w.z = cvt_pk_bf16(v1[0], v1[1]); w.w = cvt_pk_bf16(v1[2], v1[3]);
                            *(u32x4*)(out + off + bj * HALF) = w; } }
                    asm volatile("" ::: "memory"); }
        } else { const bf16_t* bp = (const bf16_t*)base;
#pragma unroll
            for (int ai = 0; ai < 2; ++ai) { u32x4 bs[4][2];
#pragma unroll
                for (int m = 0; m < 4; ++m) { const size_t off = (size_t)(row0 + ai * HALF + m * 16) * ldc + col0;
#pragma unroll
                    for (int bj = 0; bj < 2; ++bj) bs[m][bj] = *(const u32x4*)(bp + off + bj * HALF); }
#pragma unroll
                for (int m = 0; m < 4; ++m) { const size_t off = (size_t)(row0 + ai * HALF + m * 16) * ldc + col0;
#pragma unroll
                    for (int bj = 0; bj < 2; ++bj) { const u32x4 r = bs[m][bj]; const f32x4 a0 = acc[ai][bj][m][0], a1 = acc[ai][bj][m][1];
                        u32x4 w;
                        w.x = cvt_pk_bf16(__builtin_bit_cast(float, r.x << 16) + gv[bj][0][0] * a0[0], __builtin_bit_cast(float, r.x & 0xffff0000u) + gv[bj][0][1] * a0[1]);
                        w.y = cvt_pk_bf16(__builtin_bit_cast(float, r.y << 16) + gv[bj][0][2] * a0[2], __builtin_bit_cast(float, r.y & 0xffff0000u) + gv[bj][0][3] * a0[3]);
                        w.z = cvt_pk_bf16(__builtin_bit_cast(float, r.z << 16) + gv[bj][1][0] * a1[0], __builtin_bit_cast(float, r.z & 0xffff0000u) + gv[bj][1][1] * a1[1]);
                        w.w = cvt_pk_bf16(__builtin_bit_cast(float, r.w << 16) + gv[bj][1][2] * a1[2], __builtin_bit_cast(float, r.w & 0xffff0000u) + gv[bj][1][3] * a1[3]);
                        *(u32x4*)(out + off + bj * HALF) = w; } }
                asm volatile("" ::: "memory"); }
        }
    }
};
template <class Epi, class Sched, bool ALIGN_EPI = false, bool SP2 = false>
__device__ __forceinline__ void gemm_phase(PG8_LAS unsigned char* lds, const Gemm g, const Sched& S, const Epi& E) {
    int tid = threadIdx.x; asm volatile("" : "+v"(tid));
    const int wid = __builtin_amdgcn_readfirstlane(tid >> 6), lane = tid & 63, wr = wid >> 2, wc = wid & 3, fr = lane & 15, fq = lane >> 4;
    const int K = g.K, nt = K / BK;
    unsigned voffA[2], voffB[2];
#pragma unroll
    for (int i = 0; i < 2; ++i) { int R, C; stage_rc(tid * 16 + i * 8192, R, C); const int Rb = Epi::PERM ? ((R & ~31) + perm32(R & 31)) : R;
        voffA[i] = (unsigned)(R * K + C) * 2u; voffB[i] = (unsigned)(Rb * K + C) * 2u; }
    const size_t kstep = (size_t)(BK * 2);
    const size_t hstep = (size_t)HALF * K * 2;
    const size_t tstep = 2 * hstep;
    const unsigned ldsw = (unsigned)wid * 1024u;
    const int aoff = lds_byte(wr * 64 + fr, fq * 8), boff = lds_byte(wc * 32 + fr, fq * 8);
#define PG8_SA(b, h) (((b) * 2 + (h)) * HTB)
#define PG8_SB(b, h) ((4 + (b) * 2 + (h)) * HTB)
#define PG8_STAGE(bufoff, gbase, voff) do { _Pragma("unroll") for (int _i = 0; _i < 2; ++_i) \
        __builtin_amdgcn_global_load_lds((const unsigned*)((const char*)(gbase) + (voff)[_i]), (PG8_LAS unsigned*)(lds + (bufoff) + ldsw + _i * 8192), 16, 0, 0); } while (0)
#define PG8_LDA(dst, b, h) do { _Pragma("unroll") for (int m = 0; m < 4; ++m) _Pragma("unroll") for (int k = 0; k < 2; ++k) dst[m][k] = *(const PG8_LAS bf16x8*)(lds + PG8_SA(b, h) + aoff + m * 2048 + k * 1024); } while (0)
#define PG8_LDB(dst, b, h) do { _Pragma("unroll") for (int n = 0; n < 2; ++n) _Pragma("unroll") for (int k = 0; k < 2; ++k) dst[n][k] = *(const PG8_LAS bf16x8*)(lds + PG8_SB(b, h) + boff + n * 2048 + k * 1024); } while (0)
#define PG8_MMA(ai, bj, At, Bt) do { __builtin_amdgcn_s_setprio(1); _Pragma("unroll") for (int m = 0; m < 4; ++m) _Pragma("unroll") for (int n = 0; n < 2; ++n) _Pragma("unroll") for (int k = 0; k < 2; ++k) \
        acc[ai][bj][m][n] = __builtin_amdgcn_mfma_f32_16x16x32_bf16(Bt[n][k], At[m][k], acc[ai][bj][m][n], 0, 0, 0); __builtin_amdgcn_s_setprio(0); } while (0)
#define PG8_WAIT_V(n) asm volatile("s_waitcnt vmcnt(" #n ")" ::: "memory")
#define PG8_WAIT_L(n) asm volatile("s_waitcnt lgkmcnt(" #n ")" ::: "memory")
#define PG8_BAR __builtin_amdgcn_s_barrier()
#define PG8_SCHED __builtin_amdgcn_sched_barrier(0)
    Unit cur, nxt; int ui = 0;
    if (!S.next(0, cur)) return;
    f32x4 acc[2][2][4][2];
#pragma unroll
    for (int a = 0; a < 2; ++a)
#pragma unroll
        for (int b = 0; b < 2; ++b)
#pragma unroll
            for (int m = 0; m < 4; ++m)
#pragma unroll
                for (int n = 0; n < 2; ++n) acc[a][b][m][n] = (f32x4){0.f, 0.f, 0.f, 0.f};
    bf16x8 At[4][2], B0[2][2], B1[2][2];
    const char* cA = (const char*)g.A + (size_t)cur.pm * tstep; const char* cB = (const char*)g.Bt + (size_t)cur.pn * tstep;
    S.a_ready(cur);
    if constexpr (SP2) {
        PG8_STAGE(PG8_SB(0, 0), cB, voffB); PG8_STAGE(PG8_SB(0, 1), cB + hstep, voffB); PG8_STAGE(PG8_SA(0, 0), cA, voffA); PG8_STAGE(PG8_SA(0, 1), cA + hstep, voffA);
        if (wr == 1) PG8_BAR;
        PG8_WAIT_V(2); PG8_BAR;
        PG8_STAGE(PG8_SB(1, 0), cB + kstep, voffB); PG8_STAGE(PG8_SA(1, 0), cA + kstep, voffA); PG8_STAGE(PG8_SB(1, 1), cB + hstep + kstep, voffB);
        PG8_WAIT_V(6); PG8_BAR;
    } else {
        PG8_STAGE(PG8_SB(0, 0), cB, voffB); PG8_STAGE(PG8_SA(0, 0), cA, voffA); PG8_STAGE(PG8_SB(0, 1), cB + hstep, voffB); PG8_STAGE(PG8_SA(0, 1), cA + hstep, voffA);
        if (wr == 1) PG8_BAR;
        PG8_WAIT_V(4); PG8_BAR;
        PG8_STAGE(PG8_SB(1, 0), cB + kstep, voffB); PG8_STAGE(PG8_SA(1, 0), cA + kstep, voffA); PG8_STAGE(PG8_SB(1, 1), cB + hstep + kstep, voffB);
        PG8_WAIT_V(6); PG8_BAR;
    }
    for (;;) {
        const bool has_next = S.next(ui + 1, nxt);
        const char* nA = has_next ? (const char*)g.A + (size_t)nxt.pm * tstep : cA; const char* nB = has_next ? (const char*)g.Bt + (size_t)nxt.pn * tstep : cB;
        for (int t = 0; t < nt; t += 2) {
            const bool last = (t == nt - 2);
            const char* a1 = cA + (size_t)(t + 1) * kstep;
            const char* a2 = last ? nA : cA + (size_t)(t + 2) * kstep; const char* b2 = last ? nB : cB + (size_t)(t + 2) * kstep;
            const char* a3 = a2 + kstep; const char* b3 = b2 + kstep;
            if (last && has_next) S.a_ready(nxt);
            if constexpr (SP2) {
            PG8_LDB(B0, 0, 0); PG8_LDB(B1, 0, 1); PG8_SCHED; PG8_LDA(At, 0, 0); PG8_STAGE(PG8_SA(1, 1), a1 + hstep, voffA);
            PG8_WAIT_V(8); PG8_WAIT_L(0); PG8_BAR; PG8_MMA(0, 0, At, B0); PG8_MMA(0, 1, At, B1); PG8_BAR; PG8_SCHED;
            PG8_LDA(At, 0, 1); PG8_STAGE(PG8_SB(0, 0), b2, voffB); PG8_STAGE(PG8_SB(0, 1), b2 + hstep, voffB); PG8_STAGE(PG8_SA(0, 0), a2, voffA);
            PG8_WAIT_V(8); PG8_WAIT_L(0); PG8_BAR; PG8_MMA(1, 0, At, B0); PG8_MMA(1, 1, At, B1); PG8_BAR; PG8_SCHED;
            PG8_LDB(B0, 1, 0); PG8_LDB(B1, 1, 1); PG8_SCHED; PG8_LDA(At, 1, 0); PG8_STAGE(PG8_SA(0, 1), a2 + hstep, voffA);
            PG8_WAIT_V(8); PG8_WAIT_L(0); PG8_BAR; PG8_MMA(0, 0, At, B0); PG8_MMA(0, 1, At, B1); PG8_BAR; PG8_SCHED;
            PG8_LDA(At, 1, 1); PG8_STAGE(PG8_SB(1, 0), b3, voffB); PG8_STAGE(PG8_SB(1, 1), b3 + hstep, voffB); PG8_STAGE(PG8_SA(1, 0), a3, voffA);
            PG8_WAIT_V(8); PG8_WAIT_L(0); PG8_BAR; PG8_MMA(1, 0, At, B0); PG8_MMA(1, 1, At, B1); PG8_BAR; PG8_SCHED;
            } else {
            PG8_LDB(B0, 0, 0); PG8_SCHED; PG8_LDA(At, 0, 0); PG8_STAGE(PG8_SA(1, 1), a1 + hstep, voffA);
            PG8_WAIT_L(8); PG8_BAR; PG8_WAIT_L(0); PG8_MMA(0, 0, At, B0); PG8_BAR; PG8_SCHED;
            PG8_LDB(B1, 0, 1); PG8_STAGE(PG8_SB(0, 0), b2, voffB);
            PG8_BAR; PG8_WAIT_L(0); PG8_MMA(0, 1, At, B1); PG8_BAR;
            PG8_LDA(At, 0, 1); PG8_STAGE(PG8_SA(0, 0), a2, voffA);
            PG8_BAR; PG8_WAIT_L(0); PG8_MMA(1, 0, At, B0); PG8_BAR; PG8_SCHED;
            PG8_STAGE(PG8_SB(0, 1), b2 + hstep, voffB);
            PG8_WAIT_V(6); PG8_BAR; PG8_MMA(1, 1, At, B1); PG8_BAR;
            PG8_LDB(B0, 1, 0); PG8_SCHED; PG8_LDA(At, 1, 0); PG8_STAGE(PG8_SA(0, 1), a2 + hstep, voffA);
            PG8_WAIT_L(8); PG8_BAR; PG8_WAIT_L(0); PG8_MMA(0, 0, At, B0); PG8_BAR; PG8_SCHED;
            PG8_LDB(B1, 1, 1); PG8_STAGE(PG8_SB(1, 0), b3, voffB);
            PG8_BAR; PG8_WAIT_L(0); PG8_MMA(0, 1, At, B1); PG8_BAR;
            PG8_LDA(At, 1, 1); PG8_STAGE(PG8_SA(1, 0), a3, voffA);
            PG8_BAR; PG8_WAIT_L(0); PG8_MMA(1, 0, At, B0); PG8_BAR; PG8_SCHED;
            PG8_STAGE(PG8_SB(1, 1), b3 + hstep, voffB);
            PG8_WAIT_V(6); PG8_BAR; PG8_MMA(1, 1, At, B1); PG8_BAR;
            }
        }
        if constexpr (ALIGN_EPI) { if (wr == 0) PG8_BAR; }
        if constexpr (!Epi::AFTER_DRAIN) { E(acc, cur, wr, wc, fr, fq); S.done(cur); }
        if (!has_next) break;
#pragma unroll
        for (int a = 0; a < 2; ++a)
#pragma unroll
            for (int b = 0; b < 2; ++b)
#pragma unroll
                for (int m = 0; m < 4; ++m)
#pragma unroll
                    for (int n = 0; n < 2; ++n) acc[a][b][m][n] = (f32x4){0.f, 0.f, 0.f, 0.f};
        cur = nxt; cA = nA; cB = nB; ++ui;
        if constexpr (ALIGN_EPI) { if (wr == 1) PG8_BAR; }
    }
    PG8_WAIT_V(0);
    if constexpr (!ALIGN_EPI) { if (wr == 0) PG8_BAR; }
    PG8_BAR;
    if constexpr (Epi::AFTER_DRAIN) { E.fused(acc, cur, wr, wc, fr, fq, lds, wid, lane); S.done(cur); }
#undef PG8_SA
#undef PG8_SB
#undef PG8_STAGE
#undef PG8_LDA
#undef PG8_LDB
#undef PG8_MMA
#undef PG8_WAIT_V
#undef PG8_WAIT_L
#undef PG8_BAR
#undef PG8_SCHED
}
}

constexpr int BATCH = 2, SEQ = 4096, DM = 2048, DEPTH = 4, M = BATCH * SEQ;
constexpr int NIN = 5919, NINP = 6144, DFF = 5632, NGU = 2 * DFF, NADA = 6 * DM;
constexpr int C_FOXQ = 0, C_FOXK = 448, C_FOXV = 896, C_NSAQ = 1344, C_CMPK = 1856, C_CMPV = 1984, C_SLCK = 2112, C_SLCV = 2240, C_WINK = 2368, C_WINV = 2496,
              C_DILQ = 2624, C_DILK = 3200, C_DILV = 3776, C_DIFQ = 4352, C_DIFK = 4864, C_DIFV = 5376, C_FOXF = 5888, C_GATE = 5896;
constexpr int O_FOX = 0, O_NSA = 448, O_DIL = 960, O_DIF = 1536;
constexpr size_t MiB = 1u << 20;
constexpr size_t WS_CTL = 0, CTL_ZERO_BYTES = 1 * MiB;
constexpr size_t WS_MOD = 1 * MiB;
constexpr size_t WS_CUM = 2 * MiB;
constexpr size_t WS_KC = 3 * MiB;
constexpr size_t WS_VCB = 3 * MiB + 512 * 1024;
constexpr size_t WS_SEL = 4 * MiB;
constexpr size_t WS_W1T = 5 * MiB;
constexpr size_t WS_W2T = 7 * MiB;
constexpr size_t WS_PW1 = 7 * MiB + 64 * 1024;
constexpr size_t WS_U = 8 * MiB;
constexpr size_t WS_O = 40 * MiB;
constexpr size_t WS_H = 72 * MiB;
constexpr size_t WS_PROJ = 136 * MiB;
constexpr size_t WS_ACT = 232 * MiB;
constexpr size_t WS_W = 320 * MiB;
constexpr size_t W_IN = 0, W_OUT = 24 * MiB, W_GU = 32 * MiB, W_D = 76 * MiB, W_LAYER = 98 * MiB;
constexpr size_t WS_VTB = WS_W + DEPTH * W_LAYER;
constexpr size_t WS_STASH = WS_VTB + 28 * MiB;
constexpr size_t WS_END = WS_STASH + 64 * MiB;
static_assert((size_t)NINP * DM * 2 == 24 * MiB && (size_t)NGU * DM * 2 == 44 * MiB && (size_t)DM * DFF * 2 == 22 * MiB, "weight copy sizes");
constexpr int CW_BAR = 4096;
constexpr int CW_WQ = 16384;
constexpr int RING_BYTES = 131072, LDSCTL_OFF = RING_BYTES, MISC_OFF = LDSCTL_OFF + 320, LDS_BYTES = 147456;
constexpr int NWAVES = 8;
constexpr int NPL = 9, NPH = 2 + DEPTH * NPL;
#ifndef N_LAUNCH_MODE
#define N_LAUNCH_MODE 0
#endif

#define GAS __attribute__((address_space(1)))
#define LAS __attribute__((address_space(3)))
typedef unsigned short bf16;
typedef unsigned v4u __attribute__((ext_vector_type(4)));
typedef unsigned v2u __attribute__((ext_vector_type(2)));
typedef float f32x4 __attribute__((ext_vector_type(4)));
typedef GAS unsigned gu32;
#define RLX_AGENT __ATOMIC_RELAXED, __HIP_MEMORY_SCOPE_AGENT
#define LDS_WAIT() asm volatile("s_waitcnt lgkmcnt(0)" ::: "memory")
#define VM_WAIT() asm volatile("s_waitcnt vmcnt(0)" ::: "memory")
__device__ __forceinline__ unsigned f2bf(float f) { unsigned u = __builtin_bit_cast(unsigned, f); return (u + 0x7fffu + ((u >> 16) & 1u)) >> 16; }
typedef float pk2_f2_t __attribute__((ext_vector_type(2))); typedef __bf16 pk2_b2_t __attribute__((ext_vector_type(2)));
__device__ __forceinline__ unsigned pk2(float lo, float hi) { pk2_f2_t v = {lo, hi}; pk2_b2_t b = __builtin_convertvector(v, pk2_b2_t); return __builtin_bit_cast(unsigned, b); }
__device__ __forceinline__ float bf2f(bf16 x) { return __builtin_bit_cast(float, (unsigned)x << 16); }
__device__ __forceinline__ float lo16(unsigned w) { return __builtin_bit_cast(float, w << 16); }
__device__ __forceinline__ float hi16(unsigned w) { return __builtin_bit_cast(float, w & 0xffff0000u); }
template <int K> __device__ __forceinline__ int lx_i(int v) { static_assert(K >= 1 && K < 32, ""); return __builtin_amdgcn_ds_swizzle(v, (K << 10) | 0x1f); }
template <int K> __device__ __forceinline__ float lx(float v) { return __builtin_bit_cast(float, lx_i<K>(__builtin_bit_cast(int, v))); }
__device__ __forceinline__ void half_swap(unsigned u, unsigned& a, unsigned& b) { unsigned u2 = u; asm volatile("" : "+v"(u2)); const auto r = __builtin_amdgcn_permlane32_swap(u, u2, false, false); a = r[0]; b = r[1]; }
__device__ __forceinline__ float half_sum(float v) { unsigned a, b; half_swap(__builtin_bit_cast(unsigned, v), a, b); return __builtin_bit_cast(float, a) + __builtin_bit_cast(float, b); }
__device__ __forceinline__ float half_max(float v) { unsigned a, b; half_swap(__builtin_bit_cast(unsigned, v), a, b); return fmaxf(__builtin_bit_cast(float, a), __builtin_bit_cast(float, b)); }
__device__ __forceinline__ unsigned half_or(unsigned u) { unsigned a, b; half_swap(u, a, b); return a | b; }
__device__ __forceinline__ float half_other(float v, int hh  ) { unsigned a, b; half_swap(__builtin_bit_cast(unsigned, v), a, b); return __builtin_bit_cast(float, hh ? a : b); }

#define XB_TMO      128
#define XB_XCNT(j)  (256  + 64 * (j))
#define XB_XSUB(j)  (1280 + 64 * (j))
#define XB_XGEN(j)  (2304 + 64 * (j))
#define XB_TOP      3328
#define XB_TOPGEN   3392
#define XCD_BAR_WORDS 3456
#define XB_SPIN_CAP (1u << 18)

__device__ __forceinline__ unsigned xb_ld(unsigned* p)              { return __hip_atomic_load(p, __ATOMIC_RELAXED, __HIP_MEMORY_SCOPE_AGENT); }
__device__ __forceinline__ unsigned xb_add(unsigned* p, unsigned v) { return __hip_atomic_fetch_add(p, v, __ATOMIC_RELAXED, __HIP_MEMORY_SCOPE_AGENT); }
__device__ __forceinline__ unsigned xb_xcc_id() { return (unsigned)__builtin_amdgcn_s_getreg((3 << 11) | 20) & 0xFu; }
#define XB_SPIN(cond, bar) do { unsigned _sp = 0; while (cond) { __builtin_amdgcn_s_sleep(1); \
    if ((++_sp & 255u) == 0u) { if (xb_ld(&(bar)[XB_TMO])) break; if (_sp > XB_SPIN_CAP) { atomicAdd(&(bar)[XB_TMO], 1u); break; } } } } while (0)

struct XcdBarrier {
    unsigned* bar; unsigned x;
    volatile LAS unsigned* st;
};

__device__ __forceinline__ XcdBarrier xcd_barrier_post(unsigned* bar, volatile LAS unsigned* st) {
    XcdBarrier b; b.bar = bar; b.x = xb_xcc_id(); b.st = st;
    if (threadIdx.x == 0) (void)xb_add(&bar[XB_XCNT(b.x)], 1u);
    return b;
}
__device__ __forceinline__ void xcd_barrier_complete(unsigned* bar, unsigned x, unsigned& nloc, unsigned& nx) {
    const unsigned G = gridDim.x * gridDim.y * gridDim.z;
    unsigned sum, cnt, mine, sp = 0u;
    for (;;) {
        sum = 0u; cnt = 0u; mine = 0u;
#pragma unroll
        for (unsigned j = 0; j < 16; ++j) { const unsigned c = xb_ld(&bar[XB_XCNT(j)]); sum += c; cnt += (c > 0u) ? 1u : 0u; mine = (j == x) ? c : mine; }
        if (sum == G) break;
        __builtin_amdgcn_s_sleep(1);
        if ((++sp & 255u) == 0u) { if (xb_ld(&bar[XB_TMO])) break; if (sp > XB_SPIN_CAP) { atomicAdd(&bar[XB_TMO], 1u); break; } }
    }
    nloc = mine > 0u ? mine : 1u; nx = cnt > 0u ? cnt : 1u;
}

__device__ __forceinline__ void xcd_barrier(const XcdBarrier& b) {
    asm volatile("s_waitcnt vmcnt(0)" ::: "memory");
    __syncthreads();
    if (threadIdx.x == 0) {
        unsigned* bar = b.bar;
        __builtin_amdgcn_s_waitcnt(0);
        unsigned nloc = b.st[0], nx = b.st[1];
        if (nloc == 0u) { xcd_barrier_complete(bar, b.x, nloc, nx); b.st[0] = nloc; b.st[1] = nx; }
        const unsigned old = xb_add(&bar[XB_XSUB(b.x)], 1u);
        const unsigned gen = old / nloc;
        if (old + 1u == (gen + 1u) * nloc) {
            __builtin_amdgcn_fence(__ATOMIC_RELEASE, "agent");
            asm volatile("s_waitcnt vmcnt(0)" ::: "memory");
            const unsigned og = xb_add(&bar[XB_TOP], 1u);
            const unsigned tg = og / nx;
            if (og + 1u == (tg + 1u) * nx) xb_add(&bar[XB_TOPGEN], 1u);
            else XB_SPIN(xb_ld(&bar[XB_TOPGEN]) == tg, bar);
            __builtin_amdgcn_fence(__ATOMIC_ACQUIRE, "agent");
            xb_add(&bar[XB_XGEN(b.x)], 1u);
            asm volatile("s_waitcnt vmcnt(0)" ::: "memory");
        } else {
            XB_SPIN(xb_ld(&bar[XB_XGEN(b.x)]) == gen, bar);
            __builtin_amdgcn_fence(__ATOMIC_ACQUIRE, "agent");
            asm volatile("s_waitcnt vmcnt(0)" ::: "memory");
        }
    }
    __syncthreads();
}

__device__ __forceinline__ float wave_sum(float v) { v += lx<1>(v); v += lx<2>(v); v += lx<4>(v); v += lx<8>(v); v += lx<16>(v); return half_sum(v); }
__device__ __forceinline__ float wave_max(float v) { v = fmaxf(v, lx<1>(v)); v = fmaxf(v, lx<2>(v)); v = fmaxf(v, lx<4>(v)); v = fmaxf(v, lx<8>(v)); v = fmaxf(v, lx<16>(v)); return half_max(v); }
__device__ __forceinline__ void load_row64(const bf16* p, float (&q)[64]) {
#pragma unroll
    for (int c = 0; c < 8; ++c) { const v4u w = ((const v4u*)p)[c];
        q[8 * c + 0] = lo16(w.x); q[8 * c + 1] = hi16(w.x); q[8 * c + 2] = lo16(w.y); q[8 * c + 3] = hi16(w.y);
        q[8 * c + 4] = lo16(w.z); q[8 * c + 5] = hi16(w.z); q[8 * c + 6] = lo16(w.w); q[8 * c + 7] = hi16(w.w); }
}
__device__ __forceinline__ float dot64(const float (&q)[64], const bf16* p) {
    float a0 = 0.f, a1 = 0.f, a2 = 0.f, a3 = 0.f;
#pragma unroll
    for (int c = 0; c < 8; ++c) { const v4u w = ((const v4u*)p)[c];
        a0 = fmaf(q[8 * c + 0], lo16(w.x), a0); a1 = fmaf(q[8 * c + 1], hi16(w.x), a1); a2 = fmaf(q[8 * c + 2], lo16(w.y), a2); a3 = fmaf(q[8 * c + 3], hi16(w.y), a3);
        a0 = fmaf(q[8 * c + 4], lo16(w.z), a0); a1 = fmaf(q[8 * c + 5], hi16(w.z), a1); a2 = fmaf(q[8 * c + 6], lo16(w.w), a2); a3 = fmaf(q[8 * c + 7], hi16(w.w), a3);
        if ((c & 3) == 3) asm volatile("" ::: "memory"); }
    return (a0 + a1) + (a2 + a3);
}
template <int N8> __device__ __forceinline__ void att_update(float sc, bool valid, const bf16* vrow, float& m, float& l, float (&o)[8 * N8]) {
    if (valid) {
        if (sc > m) { const float corr = __expf(m - sc); l *= corr;
#pragma unroll
            for (int d = 0; d < 8 * N8; ++d) o[d] *= corr;
            m = sc; }
        const float p = __expf(sc - m); l += p;
#pragma unroll
        for (int c = 0; c < N8; ++c) { const v4u w = ((const v4u*)vrow)[c];
            o[8 * c + 0] = fmaf(p, lo16(w.x), o[8 * c + 0]); o[8 * c + 1] = fmaf(p, hi16(w.x), o[8 * c + 1]); o[8 * c + 2] = fmaf(p, lo16(w.y), o[8 * c + 2]); o[8 * c + 3] = fmaf(p, hi16(w.y), o[8 * c + 3]);
            o[8 * c + 4] = fmaf(p, lo16(w.z), o[8 * c + 4]); o[8 * c + 5] = fmaf(p, hi16(w.z), o[8 * c + 5]); o[8 * c + 6] = fmaf(p, lo16(w.w), o[8 * c + 6]); o[8 * c + 7] = fmaf(p, hi16(w.w), o[8 * c + 7]);
            if ((c & 3) == 3) asm volatile("" ::: "memory"); }
    }
}
template <int N8> __device__ __forceinline__ void store_row(bf16* p, const float (&o)[8 * N8], float s) {
#pragma unroll
    for (int c = 0; c < N8; ++c) { v4u w; w.x = pk2(o[8 * c + 0] * s, o[8 * c + 1] * s); w.y = pk2(o[8 * c + 2] * s, o[8 * c + 3] * s); w.z = pk2(o[8 * c + 4] * s, o[8 * c + 5] * s); w.w = pk2(o[8 * c + 6] * s, o[8 * c + 7] * s);
        ((v4u*)p)[c] = w; }
}
__device__ __forceinline__ float log_sigmoid(float x) { return fminf(x, 0.f) - log1pf(__expf(-fabsf(x))); }
__device__ __forceinline__ float sigmoidf_(float x) { return __builtin_amdgcn_rcpf(1.f + __builtin_amdgcn_exp2f(-1.4426950408889634f * x)); }
__device__ __forceinline__ float gelu_tanh(float x) { const float u = 0.7978845608028654f * (x + 0.044715f * x * x * x); return x * __builtin_amdgcn_rcpf(1.f + __builtin_amdgcn_exp2f(-2.885390081777927f * u)); }

__device__ __forceinline__ void tr_item(const float* W, int K, int N, int srccol, bf16* WT, int destrow0, int k0, LAS float* scr, int lane) {
#pragma unroll 8
    for (int i = 0; i < 32; ++i) { const int kk = 2 * i + (lane >> 5); scr[kk * 33 + (lane & 31)] = srccol >= 0 ? W[(size_t)(k0 + kk) * N + srccol] : 0.f; }
    LDS_WAIT(); asm volatile("" ::: "memory");
    const int c = lane & 7;
#pragma unroll
    for (int j = 0; j < 4; ++j) { const int n = (lane >> 3) + 8 * j; const LAS float* s = scr + (8 * c) * 33 + n;
        v4u o; o.x = pk2(s[0 * 33], s[1 * 33]); o.y = pk2(s[2 * 33], s[3 * 33]); o.z = pk2(s[4 * 33], s[5 * 33]); o.w = pk2(s[6 * 33], s[7 * 33]);
        *(v4u*)(WT + (size_t)(destrow0 + n) * K + k0 + 8 * c) = o; }
    LDS_WAIT(); asm volatile("" ::: "memory");
}
__device__ __forceinline__ int src_col_in(int n) {
    if (n < 1344) return n;
    if (n < 2624) return n + 7;
    if (n < 5888) return n + 31;
    if (n < 5895) return n - 5888 + 1344;
    if (n >= 5896 && n < 5920) return n - 5896 + 2631;
    return -1;
}
__device__ __forceinline__ void tr64_item(const float* W, int K, int N, int srccol, bf16* WT, int destrow0  , int k0, LAS unsigned char* scr, int lane) {
    const float* src = W + (size_t)k0 * N + (srccol >= 0 ? srccol : 0);
#pragma unroll
    for (int h = 0; h < 2; ++h) { float v[32];
#pragma unroll
        for (int i = 0; i < 32; ++i) v[i] = srccol >= 0 ? src[(size_t)(32 * h + i) * N] : 0.f;
#pragma unroll
        for (int c = 0; c < 4; ++c) { v4u o; o.x = pk2(v[8 * c], v[8 * c + 1]); o.y = pk2(v[8 * c + 2], v[8 * c + 3]); o.z = pk2(v[8 * c + 4], v[8 * c + 5]); o.w = pk2(v[8 * c + 6], v[8 * c + 7]);
            *(LAS v4u*)(scr + lane * 128 + (((4 * h + c) ^ (lane & 7)) << 4)) = o; } }
    LDS_WAIT(); asm volatile("" ::: "memory");
    const int r = lane >> 3, c = lane & 7;
#pragma unroll
    for (int j = 0; j < 8; ++j) { const int n = r + 8 * j; const v4u o = *(const LAS v4u*)(scr + n * 128 + ((c ^ (n & 7)) << 4));
        *(v4u*)(WT + (size_t)(destrow0 + n) * K + k0 + 8 * c) = o; }
    LDS_WAIT(); asm volatile("" ::: "memory");
}
constexpr int I_IN = (DM / 64) * (NINP / 64), I_OUT = (DM / 64) * (DM / 64), I_GU = (DM / 64) * (NGU / 64), I_D = (DFF / 64) * (DM / 64), I_LAYER = I_IN + I_OUT + I_GU + I_D;
__device__ __forceinline__ void conv_item(const float* w_in, const float* w_out, const float* w_gate, const float* w_up, const float* w_down, unsigned char* ws, int layer, int r, LAS unsigned char* scr, int lane) {
    {
        unsigned char* wl = ws + WS_W + (size_t)layer * W_LAYER;
        if (r < I_IN) { const int nblk = NINP / 64, kb = r / nblk, nb = r % nblk;
            tr64_item(w_in + (size_t)layer * DM * NIN, DM, NIN, src_col_in(nb * 64 + lane), (bf16*)(wl + W_IN), nb * 64, kb * 64, scr, lane); return; }
        r -= I_IN;
        if (r < I_OUT) { const int nblk = DM / 64, kb = r / nblk, nb = r % nblk;
            tr64_item(w_out + (size_t)layer * DM * DM, DM, DM, nb * 64 + lane, (bf16*)(wl + W_OUT), nb * 64, kb * 64, scr, lane); return; }
        r -= I_OUT;
        if (r < I_GU) { const int nblk = NGU / 64, kb = r / nblk, nb = r % nblk, n0 = nb * 64, pn = n0 >> 8, w0 = n0 & 255;
            const float* W = (w0 < 128 ? w_gate : w_up) + (size_t)layer * DM * DFF;
            tr64_item(W, DM, DFF, pn * 128 + (w0 & 127) + lane, (bf16*)(wl + W_GU), n0, kb * 64, scr, lane); return; }
        r -= I_GU;
        { const int nblk = DM / 64, kb = r / nblk, nb = r % nblk;
            tr64_item(w_down + (size_t)layer * DFF * DM, DFF, DM, nb * 64 + lane, (bf16*)(wl + W_D), nb * 64, kb * 64, scr, lane); }
    }
}
__device__ __forceinline__ void p0_weights(const float* w_in, const float* w_out, const float* w_gate, const float* w_up, const float* w_down, unsigned char* ws, LAS unsigned char* scr, int gw, int NGW, int lane) {
    for (int it = gw; it < I_IN + I_OUT; it += NGW) conv_item(w_in, w_out, w_gate, w_up, w_down, ws, 0, it, scr, lane);
}
__device__ __forceinline__ void p0_mod(const float* c, const float* ada_w, const float* ada_b, float* MOD, LAS unsigned char* lds, int bid, int G, int tid, int wave, int lane) {
    LAS float* cact = (LAS float*)lds;
    LAS f32x4* red = (LAS f32x4*)(lds + 16384);
    for (int i = tid; i < BATCH * DM; i += NWAVES * 64) { const float x = c[i]; cact[i] = x / (1.f + __expf(-x)); }
    __syncthreads();
    for (int it = bid; it < DEPTH * (NADA / 192); it += G) {
        const int layer = it / (NADA / 192), cg = it % (NADA / 192);
        f32x4 a0 = {0.f, 0.f, 0.f, 0.f}, a1 = {0.f, 0.f, 0.f, 0.f};
        if (lane < 48) { const float* wp = ada_w + (size_t)layer * DM * NADA + cg * 192 + lane * 4;
#pragma unroll 16
            for (int k = wave * 256; k < wave * 256 + 256; ++k) { const f32x4 w = *(const f32x4*)(wp + (size_t)k * NADA); a0 += cact[k] * w; a1 += cact[DM + k] * w; }
            red[(wave * 2 + 0) * 48 + lane] = a0; red[(wave * 2 + 1) * 48 + lane] = a1; }
        __syncthreads();
        if (tid < 2 * 192) { const int b = tid / 192, cc = tid % 192; float s = 0.f;
#pragma unroll
            for (int w = 0; w < 8; ++w) s += ((LAS float*)red)[((w * 2 + b) * 48 + (cc >> 2)) * 4 + (cc & 3)];
            MOD[(size_t)(layer * BATCH + b) * NADA + cg * 192 + cc] = s + ada_b[(size_t)layer * NADA + cg * 192 + cc]; }
        __syncthreads();
    }
}
__device__ __forceinline__ void p0_cmpw(const float* w1, const float* w2, const float* pos, unsigned char* ws, LAS unsigned char* lds, int gw, int NGW, int bid, int G, int wave, int lane) {
    LAS float* scr = (LAS float*)(lds + wave * 16384);
    for (int it = gw; it < DEPTH * 2 * 64 + DEPTH * 2 * 2; it += NGW) {
        if (it < DEPTH * 2 * 64) { const int lk = it >> 6, r = it & 63, kb = r >> 1, nb = r & 1;
            tr_item(w1 + (size_t)lk * 2048 * 64, 2048, 64, nb * 32 + (lane & 31), (bf16*)(ws + WS_W1T) + (size_t)lk * 64 * 2048, nb * 32, kb * 64, scr, lane); }
        else { const int r = it - DEPTH * 2 * 64, lk = r >> 1, nb = r & 1;
            tr_item(w2 + (size_t)lk * 64 * 64, 64, 64, nb * 32 + (lane & 31), (bf16*)(ws + WS_W2T) + (size_t)lk * 64 * 64, nb * 32, 0, scr, lane); }
    }
    __syncthreads();
    LAS float* red = (LAS float*)(lds + 12288);
    for (int it = bid; it < DEPTH * 2; it += G) {
        const float* W = w1 + (size_t)it * 2048 * 64 + lane; const float* P = pos + (size_t)it * 2048; float a = 0.f;
#pragma unroll 8
        for (int k = wave * 256; k < wave * 256 + 256; ++k) a = fmaf(P[k], W[(size_t)k * 64], a);
        red[wave * 64 + lane] = a;
        __syncthreads();
        if (wave == 0) { float s = 0.f;
#pragma unroll
            for (int w = 0; w < 8; ++w) s += red[w * 64 + lane];
            ((float*)(ws + WS_PW1))[it * 64 + lane] = s; }
        __syncthreads();
    }
}
__device__ __forceinline__ void norm_mod_rows(const float* src, const float* gain, const float* sh, const float* sc, bf16* dst, int gw, int NGW, int lane) {
    f32x4 cur[8], nxt[8], A[8], B[8]; int cb = -1;
    if (gw < M) { const GAS f32x4* xr = (const GAS f32x4*)(src + (size_t)gw * DM) + lane;
#pragma unroll
        for (int j = 0; j < 8; ++j) cur[j] = xr[64 * j]; }
#pragma unroll 1
    for (int m = gw; m < M; m += NGW) { const int b = m >> 12; const int mn = m + NGW < M ? m + NGW : m;
        { const GAS f32x4* xr = (const GAS f32x4*)(src + (size_t)mn * DM) + lane;
#pragma unroll
            for (int j = 0; j < 8; ++j) nxt[j] = xr[64 * j]; }
        if (b != cb) { cb = b;
#pragma unroll
            for (int j = 0; j < 8; ++j) { const int col = 4 * (64 * j + lane);
                const f32x4 g4 = *(const GAS f32x4*)(gain + col), s4 = *(const GAS f32x4*)(sc + (size_t)b * NADA + col); A[j] = g4 * (1.f + s4); B[j] = *(const GAS f32x4*)(sh + (size_t)b * NADA + col); } }
        __builtin_amdgcn_sched_barrier(0);
        float ss = 0.f;
#pragma unroll
        for (int j = 0; j < 8; ++j) ss += (cur[j].x * cur[j].x + cur[j].y * cur[j].y) + (cur[j].z * cur[j].z + cur[j].w * cur[j].w);
        const float rstd = rsqrtf(wave_sum(ss) * (1.f / DM) + 1e-6f);
        v2u* o8 = (v2u*)(dst + (size_t)m * DM) + lane;
#pragma unroll
        for (int j = 0; j < 8; ++j) { const f32x4 y = cur[j] * rstd * A[j] + B[j]; v2u w; w.x = pk2(y.x, y.y); w.y = pk2(y.z, y.w); o8[64 * j] = w; }
#pragma unroll
        for (int j = 0; j < 8; ++j) cur[j] = nxt[j];
    }
}
__device__ __forceinline__ void norm_mod_rows_b(const bf16* src, const float* gain, const float* sh, const float* sc, bf16* dst, int gw, int NGW, int lane) {
    v4u cur[4], nxt[4]; f32x4 A[8], B[8]; int cb = -1;
    if (gw < M) { const GAS v4u* xr = (const GAS v4u*)(src + (size_t)gw * DM) + lane;
#pragma unroll
        for (int j = 0; j < 4; ++j) cur[j] = xr[64 * j]; }
#pragma unroll 1
    for (int m = gw; m < M; m += NGW) { const int b = m >> 12; const int mn = m + NGW < M ? m + NGW : m;
        { const GAS v4u* xr = (const GAS v4u*)(src + (size_t)mn * DM) + lane;
#pragma unroll
            for (int j = 0; j < 4; ++j) nxt[j] = xr[64 * j]; }
        if (b != cb) { cb = b;
#pragma unroll
            for (int j = 0; j < 4; ++j)
#pragma unroll
                for (int h = 0; h < 2; ++h) { const int col = 8 * (64 * j + lane) + 4 * h;
                    const f32x4 g4 = *(const GAS f32x4*)(gain + col), s4 = *(const GAS f32x4*)(sc + (size_t)b * NADA + col); A[2 * j + h] = g4 * (1.f + s4); B[2 * j + h] = *(const GAS f32x4*)(sh + (size_t)b * NADA + col); } }
        __builtin_amdgcn_sched_barrier(0);
        f32x4 x[8];
#pragma unroll
        for (int j = 0; j < 4; ++j) { x[2 * j] = (f32x4){lo16(cur[j].x), hi16(cur[j].x), lo16(cur[j].y), hi16(cur[j].y)}; x[2 * j + 1] = (f32x4){lo16(cur[j].z), hi16(cur[j].z), lo16(cur[j].w), hi16(cur[j].w)}; }
        float ss = 0.f;
#pragma unroll
        for (int j = 0; j < 8; ++j) ss += (x[j].x * x[j].x + x[j].y * x[j].y) + (x[j].z * x[j].z + x[j].w * x[j].w);
        const float rstd = rsqrtf(wave_sum(ss) * (1.f / DM) + 1e-6f);
        v4u* o16 = (v4u*)(dst + (size_t)m * DM) + lane;
#pragma unroll
        for (int j = 0; j < 4; ++j) { const f32x4 y0 = x[2 * j] * rstd * A[2 * j] + B[2 * j], y1 = x[2 * j + 1] * rstd * A[2 * j + 1] + B[2 * j + 1];
            v4u w; w.x = pk2(y0.x, y0.y); w.y = pk2(y0.z, y0.w); w.z = pk2(y1.x, y1.y); w.w = pk2(y1.z, y1.w); o16[64 * j] = w; }
#pragma unroll
        for (int j = 0; j < 4; ++j) cur[j] = nxt[j];
    }
}
__device__ __forceinline__ void norm_final_rows(const bf16* src, const float* gain, float* dst, int gw, int NGW, int lane) {
    for (int m = gw; m < M; m += NGW) {
        const v4u* xr = (const v4u*)(src + (size_t)m * DM) + lane; f32x4 v[8]; float ss = 0.f;
#pragma unroll
        for (int j = 0; j < 4; ++j) { const v4u c = xr[64 * j]; v[2 * j] = (f32x4){lo16(c.x), hi16(c.x), lo16(c.y), hi16(c.y)}; v[2 * j + 1] = (f32x4){lo16(c.z), hi16(c.z), lo16(c.w), hi16(c.w)}; }
#pragma unroll
        for (int j = 0; j < 8; ++j) ss += (v[j].x * v[j].x + v[j].y * v[j].y) + (v[j].z * v[j].z + v[j].w * v[j].w);
        const float rstd = rsqrtf(wave_sum(ss) * (1.f / DM) + 1e-6f);
        float* o = dst + (size_t)m * DM;
#pragma unroll
        for (int j = 0; j < 4; ++j)
#pragma unroll
            for (int h = 0; h < 2; ++h) { const int col = 8 * (64 * j + lane) + 4 * h; const f32x4 g4 = *(const f32x4*)(gain + col); *(f32x4*)(o + col) = v[2 * j + h] * rstd * g4; }
    }
}
__device__ __forceinline__ void fox_cum_block(const bf16* PROJ, const float* fbias, float* CUM, int ci, LAS unsigned char* lds, int wave, int lane) {
    const int b = ci / 7, h = ci % 7; const float bias = fbias[h];
    const bf16* fp = PROJ + ((size_t)b * SEQ + 512 * wave + lane) * NINP + C_FOXF + h; float* cp = CUM + (size_t)(b * 7 + h) * SEQ + 512 * wave + lane;
    float x[8], vals[8]; float carry = 0.f;
#pragma unroll
    for (int u = 0; u < 8; ++u) x[u] = bf2f(fp[(size_t)(64 * u) * NINP]);
#pragma unroll
    for (int u = 0; u < 8; ++u) { float v = log_sigmoid(x[u] + bias);
#pragma unroll
        for (int o = 1; o < 64; o <<= 1) { const float y = __builtin_bit_cast(float, __builtin_amdgcn_ds_bpermute((lane - o) << 2, __builtin_bit_cast(int, v))); if (lane >= o) v += y; }
        v += carry; vals[u] = v; carry = __builtin_bit_cast(float, __builtin_amdgcn_readlane(__builtin_bit_cast(int, v), 63)); }
    LAS float* tot = (LAS float*)lds;
    if (lane == 0) tot[wave] = carry;
    __syncthreads();
    float prefix = 0.f;
    for (int w = 0; w < wave; ++w) prefix += tot[w];
#pragma unroll
    for (int u = 0; u < 8; ++u) cp[64 * u] = (vals[u] + prefix) * -8.f;
    __syncthreads();
}
__device__ __forceinline__ void nsa_select(const bf16* PROJ, const bf16* KC, unsigned long long* SEL, int gw, int NGW, int lane) {
    for (int it = gw; it < BATCH * 2 * SEQ; it += NGW) {
        const int b = it >> 13, g = (it >> 12) & 1, t = it & 4095; const size_t row = (size_t)b * SEQ + t;
        int ncv = t >= 31 ? ((t - 31) >> 4) + 1 : 0; ncv = ncv > 255 ? 255 : ncv;
        float pg[4] = {0.f, 0.f, 0.f, 0.f};
        const bf16* kcb = KC + (size_t)((0 * BATCH + b) * 2 + g) * 256 * 64;
        if (ncv > 0) {
#pragma unroll 1
            for (int jh = 0; jh < 4; ++jh) { const int h = 4 * g + jh; const float slope = exp2f(-(float)(h + 1));
                const v4u* qp = (const v4u*)(PROJ + row * NINP + C_NSAQ + h * 64);
                float s[4] = {0.f, 0.f, 0.f, 0.f}; float mx = -1e30f;
                const int cl = 4 * lane + 3 < 255 ? 4 * lane + 3 : 254;
#pragma unroll 1
                for (int ch = 0; ch < 8; ++ch) { const v4u qw = qp[ch];
#pragma unroll
                    for (int i = 0; i < 4; ++i) { const int cc = i < 3 ? 4 * lane + i : cl; const v4u w = ((const v4u*)(kcb + (size_t)cc * 64))[ch];
                        s[i] += lo16(qw.x) * lo16(w.x) + hi16(qw.x) * hi16(w.x) + lo16(qw.y) * lo16(w.y) + hi16(qw.y) * hi16(w.y) + lo16(qw.z) * lo16(w.z) + hi16(qw.z) * hi16(w.z) + lo16(qw.w) * lo16(w.w) + hi16(qw.w) * hi16(w.w); } }
#pragma unroll
                for (int i = 0; i < 4; ++i) { const int c = 4 * lane + i; const float d = s[i] * 0.125f - slope * (float)(t - 16 * c - 31); s[i] = c < ncv ? d : -1e30f; mx = fmaxf(mx, s[i]); }
                mx = wave_max(mx); float sum = 0.f;
#pragma unroll
                for (int i = 0; i < 4; ++i) { s[i] = (4 * lane + i) < ncv ? __expf(s[i] - mx) : 0.f; sum += s[i]; }
                sum = wave_sum(sum); const float inv = 1.f / sum;
#pragma unroll
                for (int i = 0; i < 4; ++i) pg[i] += s[i] * inv;
            }
        }
        float pm1 = __shfl_up(pg[3], 1); if (lane == 0) pm1 = 0.f;
        const float imp = pm1 + 2.f * (pg[0] + pg[1] + pg[2]) + pg[3];
        const bool causal = 64 * lane <= t; const int cur = t >> 6; const bool forced = lane == 0 || lane == cur || lane == cur - 1;
        const float score = causal ? (forced ? 1e4f : imp) : -1e30f;
        int rank = 0;
#pragma unroll 1
        for (int i0 = 0; i0 < 64; i0 += 8) {
#pragma unroll
            for (int ij = 0; ij < 8; ++ij) { const int i = i0 + ij; const float v = __shfl(score, i); rank += (v > score || (v == score && i < lane)) ? 1 : 0; } }
        const unsigned long long mask = __ballot(rank < 16 && causal);
        if (lane == 0) SEL[(size_t)(b * 2 + g) * SEQ + t] = mask;
    }
}
__device__ __forceinline__ void fox_item(const bf16* PROJ, const float* CUM, bf16* O, int bh, int chunk, int lane) {
    const int b = bh / 7, h = bh % 7, half = lane & 1, t = chunk * 32 + (lane >> 1), tmax = chunk * 32 + 31; const size_t row = (size_t)b * SEQ + t;
    float q[64]; load_row64(PROJ + row * NINP + C_FOXQ + h * 64, q);
    const float* cum = CUM + (size_t)(b * 7 + h) * SEQ; const float cq = cum[t];
    float m = -1e30f, l = 0.f, o[32];
#pragma unroll
    for (int d = 0; d < 32; ++d) o[d] = 0.f;
    const bf16* kb = PROJ + (size_t)b * SEQ * NINP + C_FOXK + h * 64; const bf16* vb = PROJ + (size_t)b * SEQ * NINP + C_FOXV + h * 64 + half * 32;
    for (int s = 0; s <= tmax; ++s) { const float sc = dot64(q, kb + (size_t)s * NINP) * 0.125f + cq - cum[s]; att_update<4>(sc, s <= t, vb + (size_t)s * NINP, m, l, o); }
    store_row<4>(O + row * DM + O_FOX + h * 64 + half * 32, o, 1.f / l);
}
__device__ __forceinline__ void nsa_item(const bf16* PROJ, const bf16* KC, const unsigned long long* SEL, bf16* O, int bh, int chunk, int lane) {
    const int b = bh >> 3, h = bh & 7, g = h >> 2, half = lane & 1, t0 = chunk * 32, t = t0 + (lane >> 1), tmax = t0 + 31; const size_t row = (size_t)b * SEQ + t;
    const float slope = exp2f(-(float)(h + 1));
    float q[64]; load_row64(PROJ + row * NINP + C_NSAQ + h * 64, q);
    const float g0 = sigmoidf_(bf2f(PROJ[row * NINP + C_GATE + h * 3 + 0])), g1 = sigmoidf_(bf2f(PROJ[row * NINP + C_GATE + h * 3 + 1])), g2 = sigmoidf_(bf2f(PROJ[row * NINP + C_GATE + h * 3 + 2]));
    float res[32], o[32]; float m, l;
#pragma unroll
    for (int d = 0; d < 32; ++d) res[d] = 0.f;
    {
        int ncv = t >= 31 ? ((t - 31) >> 4) + 1 : 0; ncv = ncv > 255 ? 255 : ncv;
        int ncm = tmax >= 31 ? ((tmax - 31) >> 4) + 1 : 0; ncm = ncm > 255 ? 255 : ncm;
        const bf16* kc = KC + (size_t)((0 * BATCH + b) * 2 + g) * 256 * 64; const bf16* vc = KC + (size_t)((1 * BATCH + b) * 2 + g) * 256 * 64 + half * 32;
        m = -1e30f; l = 0.f;
#pragma unroll
        for (int d = 0; d < 32; ++d) o[d] = 0.f;
        for (int c = 0; c < ncm; ++c) { const float sc = dot64(q, kc + (size_t)c * 64) * 0.125f - slope * (float)(t - 16 * c - 31); att_update<4>(sc, c < ncv, vc + (size_t)c * 64, m, l, o); }
        const float w = l > 0.f ? g0 / l : 0.f;
#pragma unroll
        for (int d = 0; d < 32; ++d) res[d] = fmaf(w, o[d], res[d]);
    }
    {
        const unsigned long long mask = SEL[(size_t)(b * 2 + g) * SEQ + t];
        const bf16* kb = PROJ + (size_t)b * SEQ * NINP + C_SLCK + g * 64; const bf16* vb = PROJ + (size_t)b * SEQ * NINP + C_SLCV + g * 64 + half * 32;
        m = -1e30f; l = 0.f;
#pragma unroll
        for (int d = 0; d < 32; ++d) o[d] = 0.f;
        for (int jb = 0; jb <= (tmax >> 6); ++jb) { const bool bit = (mask >> jb) & 1ull; if (!__any(bit ? 1 : 0)) continue;
            for (int s = 64 * jb; s < 64 * jb + 64; ++s) { const float sc = dot64(q, kb + (size_t)s * NINP) * 0.125f - slope * (float)(t - s); att_update<4>(sc, bit && s <= t, vb + (size_t)s * NINP, m, l, o); } }
        const float w = l > 0.f ? g1 / l : 0.f;
#pragma unroll
        for (int d = 0; d < 32; ++d) res[d] = fmaf(w, o[d], res[d]);
    }
    {
        const bf16* kb = PROJ + (size_t)b * SEQ * NINP + C_WINK + g * 64; const bf16* vb = PROJ + (size_t)b * SEQ * NINP + C_WINV + g * 64 + half * 32;
        m = -1e30f; l = 0.f;
#pragma unroll
        for (int d = 0; d < 32; ++d) o[d] = 0.f;
        const int s0 = t0 - 511 > 0 ? t0 - 511 : 0;
        for (int s = s0; s <= tmax; ++s) { const float sc = dot64(q, kb + (size_t)s * NINP) * 0.125f - slope * (float)(t - s); att_update<4>(sc, s <= t && t - s < 512, vb + (size_t)s * NINP, m, l, o); }
        const float w = l > 0.f ? g2 / l : 0.f;
#pragma unroll
        for (int d = 0; d < 32; ++d) res[d] = fmaf(w, o[d], res[d]);
    }
    store_row<4>(O + row * DM + O_NSA + h * 64 + half * 32, res, 1.f);
}
__device__ __forceinline__ void dil_item(const bf16* PROJ, bf16* O, int bj, int chunk, int lane) {
    const int b = bj / 3, j = bj % 3, half = lane & 1, t = chunk * 32 + (lane >> 1); const size_t row = (size_t)b * SEQ + t;
    float lse[3]; float q[64];
#pragma unroll
    for (int g = 0; g < 3; ++g) { const int head = 3 * g + j, dil = g == 0 ? 1 : (g == 1 ? 4 : 16); const float slope = exp2f(-8.f * (float)(head + 1) / 9.f);
        load_row64(PROJ + row * NINP + C_DILQ + head * 64, q);
        const bf16* kb = PROJ + (size_t)b * SEQ * NINP + C_DILK + head * 64;
        float m = -1e30f, l = 0.f;
        for (int k = 0; k <= 128; ++k) { const int s = t - k * dil; const bool valid = s >= 0; const int sc_ = valid ? s : 0;
            const float sc = dot64(q, kb + (size_t)sc_ * NINP) * 0.125f - slope * (float)(k * dil);
            if (valid) { if (sc > m) { l *= __expf(m - sc); m = sc; } l += __expf(sc - m); } }
        lse[g] = m + __logf(l);
    }
    const float mx = fmaxf(lse[0], fmaxf(lse[1], lse[2]));
    const float e0 = __expf(lse[0] - mx), e1 = __expf(lse[1] - mx), e2 = __expf(lse[2] - mx), inv = 1.f / (e0 + e1 + e2);
    float o[32];
#pragma unroll
    for (int g = 0; g < 3; ++g) { const int head = 3 * g + j, dil = g == 0 ? 1 : (g == 1 ? 4 : 16); const float slope = exp2f(-8.f * (float)(head + 1) / 9.f);
        load_row64(PROJ + row * NINP + C_DILQ + head * 64, q);
        const bf16* kb = PROJ + (size_t)b * SEQ * NINP + C_DILK + head * 64; const bf16* vb = PROJ + (size_t)b * SEQ * NINP + C_DILV + head * 64 + half * 32;
#pragma unroll
        for (int d = 0; d < 32; ++d) o[d] = 0.f;
        for (int k = 0; k <= 128; ++k) { const int s = t - k * dil; const bool valid = s >= 0; const int sc_ = valid ? s : 0;
            const float sc = dot64(q, kb + (size_t)sc_ * NINP) * 0.125f - slope * (float)(k * dil);
            if (valid) { const float p = __expf(sc - lse[g]); const bf16* vrow = vb + (size_t)sc_ * NINP;
#pragma unroll
                for (int c = 0; c < 4; ++c) { const v4u w = ((const v4u*)vrow)[c];
                    o[8 * c + 0] = fmaf(p, lo16(w.x), o[8 * c + 0]); o[8 * c + 1] = fmaf(p, hi16(w.x), o[8 * c + 1]); o[8 * c + 2] = fmaf(p, lo16(w.y), o[8 * c + 2]); o[8 * c + 3] = fmaf(p, hi16(w.y), o[8 * c + 3]);
                    o[8 * c + 4] = fmaf(p, lo16(w.z), o[8 * c + 4]); o[8 * c + 5] = fmaf(p, hi16(w.z), o[8 * c + 5]); o[8 * c + 6] = fmaf(p, lo16(w.w), o[8 * c + 6]); o[8 * c + 7] = fmaf(p, hi16(w.w), o[8 * c + 7]); } } }
        const float wg = (g == 0 ? e0 : (g == 1 ? e1 : e2)) * inv;
        store_row<4>(O + row * DM + O_DIL + head * 64 + half * 32, o, wg);
    }
}
__device__ __forceinline__ void dif_item(const bf16* PROJ, bf16* O, float lam, const float* subg, float oscale, int bh, int chunk, int lane) {
    const int b = bh >> 2, h = bh & 3, qi = lane >> 3, mm = (lane >> 2) & 1, qt = lane & 3, t = chunk * 8 + qi, tmax = chunk * 8 + 7; const size_t row = (size_t)b * SEQ + t;
    const float slope = exp2f(-2.f * (float)(h + 1));
    float q[64]; load_row64(PROJ + row * NINP + C_DIFQ + h * 128 + mm * 64, q);
    const bf16* kb = PROJ + (size_t)b * SEQ * NINP + C_DIFK + h * 128 + mm * 64; const bf16* vb = PROJ + (size_t)b * SEQ * NINP + C_DIFV + h * 128 + qt * 32;
    float m = -1e30f, l = 0.f, o[32];
#pragma unroll
    for (int d = 0; d < 32; ++d) o[d] = 0.f;
    for (int s = 0; s <= tmax; ++s) { const float sc = dot64(q, kb + (size_t)s * NINP) * 0.125f - slope * (float)(t - s); att_update<4>(sc, s <= t, vb + (size_t)s * NINP, m, l, o); }
    const float inv = 1.f / l; float ss = 0.f;
#pragma unroll
    for (int d = 0; d < 32; ++d) { const float mine = o[d] * inv; const float other = __shfl_xor(mine, 4); const float r = mm == 0 ? mine - lam * other : other - lam * mine; o[d] = r; ss = fmaf(r, r, ss); }
    ss += __shfl_xor(ss, 1); ss += __shfl_xor(ss, 2);
    const float rs = rsqrtf(ss * (1.f / 128.f) + 1e-6f) * oscale;
#pragma unroll
    for (int d = 0; d < 32; ++d) o[d] *= rs * subg[qt * 32 + d];
    if (mm == 0) store_row<4>(O + row * DM + O_DIF + h * 128 + qt * 32, o, 1.f);
}
constexpr int NI_FOX = BATCH * 7 * 128, NI_DIF = BATCH * 4 * 128, NI_NSA = BATCH * 8 * 128, NI_DIL = BATCH * 3 * 16 * 8, NI_ATT = NI_FOX + NI_DIF + NI_NSA + NI_DIL;

typedef short bf16x8 __attribute__((ext_vector_type(8)));
typedef float f32x16 __attribute__((ext_vector_type(16)));
typedef float f32x2_t __attribute__((ext_vector_type(2)));
typedef __bf16 bf16x2_t __attribute__((ext_vector_type(2)));
__device__ __forceinline__ unsigned cvtpk(float lo, float hi) { f32x2_t v = {lo, hi}; bf16x2_t b = __builtin_convertvector(v, bf16x2_t); return __builtin_bit_cast(unsigned, b); }
#define MFMA32(a, b, c) __builtin_amdgcn_mfma_f32_32x32x16_bf16((a), (b), (c), 0, 0, 0)
__device__ __forceinline__ int fresh_lane() { int l = (int)__builtin_amdgcn_mbcnt_hi(~0u, __builtin_amdgcn_mbcnt_lo(~0u, 0u)); asm volatile("" : "+v"(l)); return l; }
constexpr float LOG2E = 1.4426950408889634f, QK_SCL = 0.125f * 1.4426950408889634f;
constexpr float NEG_BIG = -1e30f;

constexpr int NHS = 28, VTB_KB = SEQ / 32;
__device__ __forceinline__ int hs_col(int hs) { return hs < 7 ? C_FOXV + 64 * hs : hs < 9 ? C_SLCV + 64 * (hs - 7) : hs < 11 ? C_WINV + 64 * (hs - 9) : hs < 20 ? C_DILV + 64 * (hs - 11) : C_DIFV + 64 * (hs - 20); }
__device__ __forceinline__ int hs_dil(int hs) { return (hs >= 14 && hs < 17) ? 4 : ((hs >= 17 && hs < 20) ? 16 : 1); }
__device__ __forceinline__ size_t vtb_off(int b, int hs, int kb) { return ((size_t)(b * NHS + hs) * VTB_KB + kb) * 4096; }
__device__ __forceinline__ int vtb_key_of_pos(int p) { const int s = p >> 4, h = (p >> 3) & 1, j = p & 7; return 16 * s + 8 * (j >> 2) + 4 * h + (j & 3); }
__device__ __forceinline__ void vprep_item(const bf16* PROJ, unsigned char* VTB, int item, LAS unsigned* s32, int lane) {
    const int kb = item % VTB_KB, hs = (item / VTB_KB) % NHS, b = item / (VTB_KB * NHS);
    const int dil = hs_dil(hs), col = hs_col(hs), tk = lane & 31, half = lane >> 5;
    const int pos = kb * 32 + tk, seg = SEQ / dil, token = pos / seg + dil * (pos % seg);
    const v4u* src = (const v4u*)(PROJ + ((size_t)b * SEQ + token) * NINP + col + 32 * half);
#pragma unroll
    for (int i = 0; i < 4; ++i) { const v4u w = src[i]; LAS unsigned* d = s32 + tk * 33 + 16 * half + 4 * i; d[0] = w.x; d[1] = w.y; d[2] = w.z; d[3] = w.w; }
    LDS_WAIT(); asm volatile("" ::: "memory");
    const LAS unsigned short* s16 = (const LAS unsigned short*)s32;
    unsigned out[16];
#pragma unroll
    for (int p = 0; p < 32; p += 2) { const unsigned lo = s16[vtb_key_of_pos(p) * 66 + 32 * half + tk], hi = s16[vtb_key_of_pos(p + 1) * 66 + 32 * half + tk]; out[p >> 1] = lo | (hi << 16); }
    v4u* dst = (v4u*)(VTB + vtb_off(b, hs, kb) + half * 2048 + tk * 64);
#pragma unroll
    for (int i = 0; i < 4; ++i) { v4u w; w.x = out[4 * i]; w.y = out[4 * i + 1]; w.z = out[4 * i + 2]; w.w = out[4 * i + 3]; dst[i] = w; }
    LDS_WAIT(); asm volatile("" ::: "memory");
}
__device__ __forceinline__ void load_qfrag(const bf16* qrow_h  , bf16x8 (&qf)[4]) {
#pragma unroll
    for (int ks = 0; ks < 4; ++ks) qf[ks] = *(const GAS bf16x8*)(qrow_h + 16 * ks);
}
__device__ __forceinline__ void load_k(const bf16* kp, bf16x8 (&kf)[4]) {
#pragma unroll
    for (int ks = 0; ks < 4; ++ks) kf[ks] = *(const GAS bf16x8*)(kp + 16 * ks);
}
template <int NDT> __device__ __forceinline__ void load_v(const unsigned char* vp0, const unsigned char* vp1, bf16x8 (&vf)[2 * NDT]) {
#pragma unroll
    for (int dt = 0; dt < NDT; ++dt) { const unsigned char* vp = (dt < 2 ? vp0 : vp1) + (dt & 1) * 2048; vf[2 * dt] = *(const GAS bf16x8*)vp; vf[2 * dt + 1] = *(const GAS bf16x8*)(vp + 32); }
}
template <int NDT>
__device__ __forceinline__ void store_ot(bf16* orow  , const f32x16 (&o)[NDT], float scale, int hh) {
#pragma unroll
    for (int dt = 0; dt < NDT; ++dt)
#pragma unroll
        for (int g = 0; g < 4; ++g) { v2u w; w.x = cvtpk(o[dt][4 * g] * scale, o[dt][4 * g + 1] * scale); w.y = cvtpk(o[dt][4 * g + 2] * scale, o[dt][4 * g + 3] * scale);
            *(v2u*)(orow + 32 * dt + 8 * g + 4 * hh) = w; }
}
template <int NDT> __device__ __forceinline__ void zero_ot(f32x16 (&o)[NDT]) {
#pragma unroll
    for (int dt = 0; dt < NDT; ++dt)
#pragma unroll
        for (int r = 0; r < 16; ++r) o[dt][r] = 0.f;
}
#define CR(r) (((r) & 3) + 8 * ((r) >> 2))
struct AlibiBase { float g, tadd; int hh; f32x16 cv;
    __device__ __forceinline__ void setup(float g_, int hh_) { g = g_; hh = hh_; asm volatile("" : "+v"(hh_));
#pragma unroll
        for (int r = 0; r < 16; ++r) cv[r] = g_ * (1.f / QK_SCL) * (float)(CR(r) + 4 * hh_); }
    __device__ __forceinline__ void set_base(float qrel  ) { tadd = -g * qrel; }
    __device__ __forceinline__ void fetch(int) {} __device__ __forceinline__ void rotate() {} __device__ __forceinline__ bool lane_on() const { return true; }
    __device__ __forceinline__ const f32x16& c1() const { return cv; } __device__ __forceinline__ const f32x16& c0() const { return cv; } __device__ __forceinline__ void fetch2(int) {} };
struct AlibiCausal : AlibiBase { int tq, t0;
    __device__ __forceinline__ void begin(int k0) { set_base((float)(tq - k0)); }
    __device__ __forceinline__ bool valid(int kk) const { return kk <= tq; }
    __device__ __forceinline__ bool needs_mask(int k0) const { return k0 + 31 > t0; } };
struct WinBias : AlibiBase { int tq, t0;
    __device__ __forceinline__ void begin(int k0) { set_base((float)(tq - k0)); }
    __device__ __forceinline__ bool valid(int kk) const { return kk <= tq && tq - kk < 512; }
    __device__ __forceinline__ bool needs_mask(int k0) const { return k0 + 31 > t0 || t0 + 31 - k0 >= 512; } };
struct SlcBias : AlibiBase { int tq; bool bit;
    __device__ __forceinline__ void begin(int k0) { set_base((float)(tq - k0)); }
    __device__ __forceinline__ bool valid(int kk) const { return bit && kk <= tq; }
    __device__ __forceinline__ bool lane_on() const { return bit; }
    __device__ __forceinline__ bool needs_mask(int) const { return true; } };
struct CmpBias : AlibiBase { int tq, ncv, ncv_min;
    __device__ __forceinline__ void begin(int k0) { set_base((float)(tq - 31 - 16 * k0) * (1.f / 16.f)); }
    __device__ __forceinline__ bool valid(int kk) const { return kk < ncv; }
    __device__ __forceinline__ bool needs_mask(int k0) const { return k0 + 31 >= ncv_min; } };
struct DilBias : AlibiBase { int iq;
    __device__ __forceinline__ void begin(int k0) { set_base((float)(iq - k0)); }
    __device__ __forceinline__ bool valid(int kk) const { return kk <= iq && iq - kk <= 128; }
    __device__ __forceinline__ bool needs_mask(int) const { return true; } };
struct FoxBias { const float* cum2; float tadd; int tq, t0, hh; f32x16 cvA, cvB;
    __device__ __forceinline__ void fetch2(int st) {
#pragma unroll
        for (int g = 0; g < 4; ++g) { const f32x4 a = *(const GAS f32x4*)(cum2 + 64 * st + 32 + 8 * g + 4 * hh), b = *(const GAS f32x4*)(cum2 + 64 * st + 8 * g + 4 * hh);
            cvA[4 * g] = a.x; cvA[4 * g + 1] = a.y; cvA[4 * g + 2] = a.z; cvA[4 * g + 3] = a.w; cvB[4 * g] = b.x; cvB[4 * g + 1] = b.y; cvB[4 * g + 2] = b.z; cvB[4 * g + 3] = b.w; } }
    __device__ __forceinline__ const f32x16& c1() const { return cvA; } __device__ __forceinline__ const f32x16& c0() const { return cvB; }
    __device__ __forceinline__ void begin(int) {} __device__ __forceinline__ bool lane_on() const { return true; }
    __device__ __forceinline__ bool valid(int kk) const { return kk <= tq; }
    __device__ __forceinline__ bool needs_mask(int k0) const { return k0 + 31 > t0; } };
struct CmpSel { float slope2; int tq, ncv;
    __device__ __forceinline__ float operator()(float raw, int kk, int) const { return kk < ncv ? fmaf(raw, QK_SCL, -slope2 * (float)(tq - 16 * kk - 31)) : NEG_BIG; } };

template <int NDT, class F>
__device__ __forceinline__ void softmax_body(f32x16& s, const F& f, int k0, int hh, f32x16 (&o)[NDT], float& m, float& l, bf16x8& pf0, bf16x8& pf1, const int MASK) {
    float mx = NEG_BIG;
    if (MASK == 1) {
#pragma unroll
        for (int r = 0; r < 16; ++r) s[r] = f.valid(k0 + CR(r) + 4 * hh) ? s[r] : NEG_BIG; }
#pragma unroll
    for (int r = 0; r < 16; ++r) mx = fmaxf(mx, s[r]);
    mx = fmaf(mx, QK_SCL, f.tadd);
    const bool on = MASK != 2 || f.lane_on();
    mx = on ? mx : NEG_BIG;
    mx = half_max(mx);
    if (__ballot(mx > m) != 0ull) { const float mn = fmaxf(m, mx), alpha = __builtin_amdgcn_exp2f(m - mn); m = mn; l *= alpha;
#pragma unroll
        for (int dt = 0; dt < NDT; ++dt) o[dt] = o[dt] * alpha; }
    const float me = fmaxf(m, -1e29f);
    const float off = on ? f.tadd - me : NEG_BIG;
    const f32x2_t sc2 = {QK_SCL, QK_SCL}, of2 = {off, off}; f32x2_t ps2 = {0.f, 0.f};
#pragma unroll
    for (int r = 0; r < 16; r += 2) { f32x2_t a = {s[r], s[r + 1]}; a = __builtin_elementwise_fma(a, sc2, of2);
        f32x2_t p; p.x = __builtin_amdgcn_exp2f(a.x); p.y = __builtin_amdgcn_exp2f(a.y); s[r] = p.x; s[r + 1] = p.y; ps2 += p; }
    l += ps2.x + ps2.y;
    v4u p0, p1;
    p0.x = cvtpk(s[0], s[1]); p0.y = cvtpk(s[2], s[3]); p0.z = cvtpk(s[4], s[5]); p0.w = cvtpk(s[6], s[7]);
    p1.x = cvtpk(s[8], s[9]); p1.y = cvtpk(s[10], s[11]); p1.z = cvtpk(s[12], s[13]); p1.w = cvtpk(s[14], s[15]);
    pf0 = __builtin_bit_cast(bf16x8, p0); pf1 = __builtin_bit_cast(bf16x8, p1);
}
template <int NDT, int MASK, class F>
__device__ __forceinline__ void softmax_tile(f32x16& s, const F& f, int k0, int hh, f32x16 (&o)[NDT], float& m, float& l, bf16x8& pf0, bf16x8& pf1) { softmax_body<NDT>(s, f, k0, hh, o, m, l, pf0, pf1, MASK); }
template <int NDT, bool MASK, class F>
__device__ __forceinline__ void att_compute(const bf16x8 (&qf)[4], const bf16x8 (&kf)[4], const bf16x8 (&vf)[2 * NDT], const F& f, int k0, int hh, f32x16 (&o)[NDT], float& m, float& l) {
    f32x16 s = MFMA32(kf[0], qf[0], f.cv);
#pragma unroll
    for (int ks = 1; ks < 4; ++ks) s = MFMA32(kf[ks], qf[ks], s);
    bf16x8 pf0, pf1; softmax_tile<NDT, MASK>(s, f, k0, hh, o, m, l, pf0, pf1);
#pragma unroll
    for (int dt = 0; dt < NDT; ++dt) { o[dt] = MFMA32(vf[2 * dt], pf0, o[dt]); o[dt] = MFMA32(vf[2 * dt + 1], pf1, o[dt]); }
}
template <int NDT, bool MASK, class F>
__device__ __forceinline__ void att_compute_lds(const bf16x8 (&qf)[4], const LAS unsigned char* cur, int fk, int fv, const F& f, int k0, int hh, f32x16 (&o)[NDT], float& m, float& l) {
    f32x16 s;
#pragma unroll
    for (int ks = 0; ks < 4; ++ks) { const bf16x8 kf = *(const LAS bf16x8*)(cur + (fk ^ (ks << 5))); s = MFMA32(kf, qf[ks], ks == 0 ? f.cv : s); }
    bf16x8 va0 = *(const LAS bf16x8*)(cur + fv), va1 = *(const LAS bf16x8*)(cur + (fv ^ 32));
    __builtin_amdgcn_sched_barrier(0);
    bf16x8 pf0, pf1; softmax_tile<NDT, MASK>(s, f, k0, hh, o, m, l, pf0, pf1);
#pragma unroll
    for (int dt = 0; dt < NDT; ++dt) { bf16x8 vb0 = va0, vb1 = va1;
        if (dt + 1 < NDT) { vb0 = *(const LAS bf16x8*)(cur + (dt + 1) * 2048 + fv); vb1 = *(const LAS bf16x8*)(cur + (dt + 1) * 2048 + (fv ^ 32)); __builtin_amdgcn_sched_barrier(0); }
        o[dt] = MFMA32(va0, pf0, o[dt]); o[dt] = MFMA32(va1, pf1, o[dt]); va0 = vb0; va1 = vb1; }
}
template <int NDT, class F>
__device__ __forceinline__ void att_range(const bf16x8 (&qf)[4], const bf16* kb, size_t kts, const unsigned char* vb0, const unsigned char* vb1, F& f, int kt0, int kt1, int hh, f32x16 (&o)[NDT], float& m, float& l) {
#pragma unroll 1
    for (int kt = kt1; kt >= kt0; --kt) {
        bf16x8 kf[4], vf[2 * NDT];
        f.fetch(32 * kt); load_k(kb + (size_t)kt * kts, kf); load_v<NDT>(vb0 + (size_t)kt * 4096, vb1 + (size_t)kt * 4096, vf);
        f.rotate(); f.begin(32 * kt);
        if (f.needs_mask(32 * kt)) att_compute<NDT, true>(qf, kf, vf, f, 32 * kt, hh, o, m, l);
        else att_compute<NDT, false>(qf, kf, vf, f, 32 * kt, hh, o, m, l);
    }
}
__device__ __forceinline__ int swz_v(int off) { const int d = (off >> 6) & 31; return (off & ~0x30) | ((((off >> 4) & 3) ^ ((d >> 2) & 3)) << 4); }
template <int K> __device__ __forceinline__ int xor_now(int x) { if (K != 0) asm volatile("v_xor_b32 %0, %1, %0" : "+v"(x) : "n"(K)); return x; }
struct WvStream { const unsigned char* kbase; const unsigned char* vbase; size_t ts; unsigned rs8, kofs, vofs; int fk, fv;
    __device__ __forceinline__ void setup(const void* kb0, size_t rs, const void* vb0, int lane) { asm volatile("" : "+v"(lane)); const int kr = lane & 31, hh = lane >> 5;
        kbase = (const unsigned char*)kb0; vbase = (const unsigned char*)vb0; ts = 32 * rs; rs8 = (unsigned)(8 * rs);
        kofs = (unsigned)(lane >> 3) * (unsigned)rs + (unsigned)((((lane & 7) ^ (lane >> 4)) << 4));
        vofs = (unsigned)swz_v(lane * 16);
        fk = kr * 128 + ((hh ^ ((kr >> 1) & 7)) << 4); fv = 4096 + kr * 64 + ((hh ^ ((kr >> 2) & 3)) << 4); }
    static __device__ __forceinline__ const unsigned char* uni(const unsigned char* p) { unsigned long long v = (unsigned long long)p; asm volatile("" : "+s"(v)); return (const unsigned char*)v; }
    __device__ __forceinline__ void dma_k(int kt, LAS unsigned char* slot) const { const unsigned char* g = kbase + (size_t)kt * ts;
#pragma unroll
        for (int i = 0; i < 4; ++i) __builtin_amdgcn_global_load_lds((const unsigned*)(uni(g + (size_t)i * rs8) + ((i & 1) ? (unsigned)xor_now<64>((int)kofs) : kofs)), (LAS unsigned*)(slot + i * 1024), 16, 0, 0); }
    __device__ __forceinline__ void dma_v(int kt, LAS unsigned char* slot) const { const unsigned char* g = vbase + (size_t)kt * 4096;
#pragma unroll
        for (int i = 0; i < 4; ++i) __builtin_amdgcn_global_load_lds((const unsigned*)(uni(g + i * 1024) + vofs), (LAS unsigned*)(slot + 4096 + i * 1024), 16, 0, 0); } };
#define VMW(n) asm volatile("s_waitcnt vmcnt(" #n ")" ::: "memory")
struct RangeIt { int kt, kt0; __device__ __forceinline__ int next() { const int r = kt >= kt0 ? kt : -1; --kt; return r; } };
template <class F> struct RangePre { F& f; static constexpr bool LANE_MODE = false; __device__ __forceinline__ int operator()(int kt) { f.begin(32 * kt); return f.needs_mask(32 * kt) ? 1 : 0; } };
template <int NDT, class F>
__device__ __forceinline__ void stream_tile(const bf16x8 (&qf)[4], const WvStream& st, LAS unsigned char* cur, LAS unsigned char* nxt, const F& f, f32x16& s, int t0, int t1, int t2, int t3, int hh, f32x16 (&o)[NDT], float& m, float& l, int msk) {
    f32x16 sn;
    if (t1 >= 0) {
        if (t2 >= 0) VMW(12); else VMW(8);
#pragma unroll
        for (int ks = 0; ks < 4; ++ks) { const bf16x8 kf = *(const LAS bf16x8*)(nxt + (ks == 0 ? st.fk : ks == 1 ? xor_now<32>(st.fk) : ks == 2 ? xor_now<64>(st.fk) : xor_now<96>(st.fk))); sn = MFMA32(kf, qf[ks], ks == 0 ? f.cv : sn); }
        if (t3 >= 0) st.dma_k(t3, nxt);
        __builtin_amdgcn_sched_barrier(0);
    }
    bf16x8 pf0, pf1; softmax_body<NDT>(s, f, 32 * t0, hh, o, m, l, pf0, pf1, msk);
    v4u tie = __builtin_bit_cast(v4u, pf0);
    if (t3 >= 0) asm volatile("s_waitcnt vmcnt(12)" : "+v"(tie.x) :: "memory");
    else if (t2 >= 0) asm volatile("s_waitcnt vmcnt(8)" : "+v"(tie.x) :: "memory");
    else if (t1 >= 0) asm volatile("s_waitcnt vmcnt(4)" : "+v"(tie.x) :: "memory");
    else asm volatile("s_waitcnt vmcnt(0)" : "+v"(tie.x) :: "memory");
    pf0 = __builtin_bit_cast(bf16x8, tie);
#pragma unroll
    for (int dt = 0; dt < NDT; ++dt) { const bf16x8 vf0 = *(const LAS bf16x8*)(cur + dt * 2048 + st.fv), vf1 = *(const LAS bf16x8*)(cur + dt * 2048 + xor_now<32>(st.fv));
        o[dt] = MFMA32(vf0, pf0, o[dt]); o[dt] = MFMA32(vf1, pf1, o[dt]); }
    if (t2 >= 0) st.dma_v(t2, cur);
    s = sn;
}
template <int NDT, class F, class It, class Pre>
__device__ __forceinline__ void att_stream(const bf16x8 (&qf)[4], const WvStream& st, LAS unsigned char* ring, F& f, It& it, Pre& pre, int hh, f32x16 (&o)[NDT], float& m, float& l) {
    static_assert(NDT == 2, "one 4 KiB V block per tile");
    int t0 = it.next(); if (t0 < 0) return;
    int t1 = it.next(), t2 = t1 >= 0 ? it.next() : -1, t3 = t2 >= 0 ? it.next() : -1;
    st.dma_k(t0, ring); if (t1 >= 0) st.dma_k(t1, ring + 8192); st.dma_v(t0, ring);
    if (t1 >= 0) VMW(8); else VMW(4);
    f32x16 s;
#pragma unroll
    for (int ks = 0; ks < 4; ++ks) { const bf16x8 kf = *(const LAS bf16x8*)(ring + (ks == 0 ? st.fk : ks == 1 ? xor_now<32>(st.fk) : ks == 2 ? xor_now<64>(st.fk) : xor_now<96>(st.fk))); s = MFMA32(kf, qf[ks], ks == 0 ? f.cv : s); }
    if (t2 >= 0) st.dma_k(t2, ring);
    if (t1 >= 0) st.dma_v(t1, ring + 8192);
    int par = 0;
#pragma unroll 1
    for (;;) {
        LAS unsigned char* cur = ring + par * 8192; LAS unsigned char* nxt = ring + (par ^ 1) * 8192;
        const int msk = pre(t0);
        stream_tile<NDT>(qf, st, cur, nxt, f, s, t0, t1, t2, t3, hh, o, m, l, msk);
        t0 = t1; t1 = t2; t2 = t3; t3 = t2 >= 0 ? it.next() : -1; par ^= 1;
        if (t0 < 0) break;
    }
}
struct SlcIt { unsigned long long um; int pend, tmax;
    __device__ __forceinline__ int next() { if (pend >= 0) { const int r = pend; pend = -1; return r; } if (um == 0ull) return -1;
        const int jb = 63 - __builtin_clzll(um); um &= ~(1ull << jb); if (32 * (2 * jb + 1) > tmax) return 2 * jb; pend = 2 * jb; return 2 * jb + 1; } };
struct SlcPre { SlcBias& f; unsigned long long mask; int t0; static constexpr bool LANE_MODE = true;
    __device__ __forceinline__ int operator()(int kt) { f.bit = (mask >> (kt >> 1)) & 1ull; const bool allsel = __ballot(f.bit ? 1 : 0) == ~0ull; f.begin(32 * kt);
        return 32 * kt + 31 <= t0 ? (allsel ? 0 : 2) : 1; } };
__device__ __forceinline__ int vtb_pos_of_key(int kk) { const int s = kk >> 4, w = kk & 15; return 16 * s + 8 * ((w >> 2) & 1) + 4 * (w >> 3) + (w & 3); }
__device__ __forceinline__ void nsa_item_mfma(const bf16* PROJ, const bf16* KC, const unsigned char* VCB, const unsigned char* VTB, const unsigned long long* SEL, bf16* O, LAS unsigned char* ring  , int bh, int qt, int lane) {
    lane = fresh_lane();
    const int b = bh >> 3, hd = bh & 7, g = hd >> 2, q = lane & 31, hh = lane >> 5, t0 = qt * 32, tq = t0 + q, tmax = t0 + 31;
#define NSA_ROW() ((size_t)b * SEQ + t0 + (fresh_lane() & 31))
    const float slope2 = __builtin_amdgcn_exp2f(-(float)(hd + 1)) * LOG2E;
    bf16x8 qf[4]; load_qfrag(PROJ + NSA_ROW() * NINP + C_NSAQ + hd * 64 + 8 * hh, qf);
    f32x16 o[2]; unsigned res[16];
    {
        const unsigned long long mask = SEL[(size_t)(b * 2 + g) * SEQ + tq];
        SlcBias f; f.setup(slope2, hh); f.tq = tq;
        WvStream st; st.setup(PROJ + (size_t)b * SEQ * NINP + C_SLCK + g * 64, (size_t)NINP * 2, VTB + vtb_off(b, 7 + g, 0), lane);
        zero_ot<2>(o); float m = NEG_BIG, l = 0.f;
        unsigned ulo = (unsigned)mask, uhi = (unsigned)(mask >> 32);
        { ulo |= (unsigned)lx_i<1>((int)ulo); uhi |= (unsigned)lx_i<1>((int)uhi); ulo |= (unsigned)lx_i<2>((int)ulo); uhi |= (unsigned)lx_i<2>((int)uhi); ulo |= (unsigned)lx_i<4>((int)ulo); uhi |= (unsigned)lx_i<4>((int)uhi);
          ulo |= (unsigned)lx_i<8>((int)ulo); uhi |= (unsigned)lx_i<8>((int)uhi); ulo |= (unsigned)lx_i<16>((int)ulo); uhi |= (unsigned)lx_i<16>((int)uhi); }
        const unsigned long long um = (unsigned long long)(unsigned)__builtin_amdgcn_readfirstlane((int)ulo) | ((unsigned long long)(unsigned)__builtin_amdgcn_readfirstlane((int)uhi) << 32);
        SlcIt it; it.um = um; it.pend = -1; it.tmax = tmax; SlcPre pre{f, mask, t0};
        att_stream<2>(qf, st, ring, f, it, pre, hh, o, m, l);
        l = half_sum(l); const float g1 = sigmoidf_(bf2f(PROJ[NSA_ROW() * NINP + C_GATE + hd * 3 + 1])); const float w = l > 0.f ? g1 / l : 0.f;
#pragma unroll
        for (int dt = 0; dt < 2; ++dt)
#pragma unroll
            for (int r = 0; r < 16; r += 2) res[dt * 8 + (r >> 1)] = cvtpk(o[dt][r] * w, o[dt][r + 1] * w);
    }
    {
        WinBias f; f.setup(slope2, hh); f.tq = tq; f.t0 = t0;
        WvStream st; st.setup(PROJ + (size_t)b * SEQ * NINP + C_WINK + g * 64, (size_t)NINP * 2, VTB + vtb_off(b, 9 + g, 0), lane);
        zero_ot<2>(o); float m = NEG_BIG, l = 0.f;
        RangeIt it; it.kt = qt; it.kt0 = t0 >= 512 ? (t0 - 512) >> 5 : 0; RangePre<WinBias> pre{f};
        att_stream<2>(qf, st, ring, f, it, pre, hh, o, m, l);
        l = half_sum(l); const float g2 = sigmoidf_(bf2f(PROJ[NSA_ROW() * NINP + C_GATE + hd * 3 + 2])); const float w = l > 0.f ? g2 / l : 0.f;
#pragma unroll
        for (int dt = 0; dt < 2; ++dt)
#pragma unroll
            for (int r = 0; r < 16; r += 2) { const unsigned pr = res[dt * 8 + (r >> 1)]; res[dt * 8 + (r >> 1)] = cvtpk(fmaf(o[dt][r], w, lo16(pr)), fmaf(o[dt][r + 1], w, hi16(pr))); }
    }
    {
        CmpBias f; f.setup(16.f * slope2, hh); f.tq = tq; f.ncv = tq >= 31 ? ((tq - 31) >> 4) + 1 : 0; f.ncv = f.ncv > 255 ? 255 : f.ncv;
        f.ncv_min = t0 >= 31 ? ((t0 - 31) >> 4) + 1 : 0; f.ncv_min = f.ncv_min > 255 ? 255 : f.ncv_min;
        int ncm = tmax >= 31 ? ((tmax - 31) >> 4) + 1 : 0; ncm = ncm > 255 ? 255 : ncm;
        WvStream st; st.setup(KC + (size_t)((0 * BATCH + b) * 2 + g) * 256 * 64, 128, VCB + (size_t)(b * 2 + g) * 8 * 4096, lane);
        zero_ot<2>(o); float m = NEG_BIG, l = 0.f;
        RangeIt it; it.kt = ((ncm + 31) >> 5) - 1; it.kt0 = 0; RangePre<CmpBias> pre{f};
        att_stream<2>(qf, st, ring, f, it, pre, hh, o, m, l);
        l = half_sum(l); const float g0 = sigmoidf_(bf2f(PROJ[NSA_ROW() * NINP + C_GATE + hd * 3 + 0])); const float w = l > 0.f ? g0 / l : 0.f;
#pragma unroll
        for (int dt = 0; dt < 2; ++dt)
#pragma unroll
            for (int r = 0; r < 16; r += 2) { const unsigned pr = res[dt * 8 + (r >> 1)]; o[dt][r] = fmaf(o[dt][r], w, lo16(pr)); o[dt][r + 1] = fmaf(o[dt][r + 1], w, hi16(pr)); }
    }
    store_ot<2>(O + NSA_ROW() * DM + O_NSA + hd * 64, o, 1.f, fresh_lane() >> 5);
#undef NSA_ROW
}
struct QuadStream { const unsigned char* kbase; const unsigned char* vbase; size_t ts; unsigned kofs, vofs; int fk, fv, wi;
    __device__ __forceinline__ void setup(const void* kb0, size_t rs, const void* vb0, int lane, int wi_) { asm volatile("" : "+v"(lane)); const int kr = lane & 31, hh = lane >> 5; wi = wi_;
        kbase = (const unsigned char*)kb0 + (size_t)(8 * wi_) * rs; vbase = (const unsigned char*)vb0 + wi_ * 1024; ts = 32 * rs;
        const int row = 8 * wi_ + (lane >> 3);
        kofs = (unsigned)(lane >> 3) * (unsigned)rs + (unsigned)((((lane & 7) ^ ((row >> 1) & 7)) << 4));
        vofs = (unsigned)swz_v(lane * 16);
        fk = kr * 128 + ((hh ^ ((kr >> 1) & 7)) << 4); fv = 4096 + kr * 64 + ((hh ^ ((kr >> 2) & 3)) << 4); }
    __device__ __forceinline__ void dma(int kt, LAS unsigned char* slot) const {
        __builtin_amdgcn_global_load_lds((const unsigned*)(WvStream::uni(kbase + (size_t)kt * ts) + kofs), (LAS unsigned*)(slot + wi * 1024), 16, 0, 0);
        __builtin_amdgcn_global_load_lds((const unsigned*)(WvStream::uni(vbase + (size_t)kt * 4096) + vofs), (LAS unsigned*)(slot + 4096 + wi * 1024), 16, 0, 0); } };
constexpr int QD = 6;
template <class F, class It, class Pre>
__device__ __forceinline__ void quad_stream(const bf16x8 (&qf)[4], const QuadStream& st, LAS unsigned char* ring, F& f, It itC, It itD, Pre& pre, int n_own, int nsteps, int hh, f32x16 (&o)[2], float& m, float& l) {
    asm volatile("s_waitcnt vmcnt(0) lgkmcnt(0)" ::: "memory"); __builtin_amdgcn_s_barrier(); asm volatile("" ::: "memory");
    int lastv = 0;
#pragma unroll
    for (int i = 0; i < QD; ++i) { int t = itD.next(); if (t < 0) t = lastv; else lastv = t; st.dma(t, ring + i * 8192); }
#pragma unroll 1
    for (int k = 0; k < nsteps; ++k) {
        asm volatile("s_waitcnt vmcnt(10) lgkmcnt(0)" ::: "memory");
        __builtin_amdgcn_s_barrier(); asm volatile("" ::: "memory");
        { int t = itD.next(); if (t < 0) t = lastv; else lastv = t; st.dma(t, ring + ((k + QD) & 7) * 8192); }
        if (k < n_own) {
            const int t0 = itC.next(); const int msk = pre(t0);
            const LAS unsigned char* cur = ring + (k & 7) * 8192;
            f32x16 s;
#pragma unroll
            for (int ks = 0; ks < 4; ++ks) { const bf16x8 kf = *(const LAS bf16x8*)(cur + (st.fk ^ (ks << 5))); s = MFMA32(kf, qf[ks], ks == 0 ? f.cv : s); }
            bf16x8 pf0, pf1; softmax_body<2>(s, f, 32 * t0, hh, o, m, l, pf0, pf1, msk);
#pragma unroll
            for (int dt = 0; dt < 2; ++dt) { const bf16x8 vf0 = *(const LAS bf16x8*)(cur + dt * 2048 + st.fv), vf1 = *(const LAS bf16x8*)(cur + dt * 2048 + (st.fv ^ 32));
                o[dt] = MFMA32(vf0, pf0, o[dt]); o[dt] = MFMA32(vf1, pf1, o[dt]); }
        }
    }
}
__device__ __forceinline__ int slc_tiles(unsigned long long um, int t0) { return um == 0ull ? 0 : 2 * __builtin_popcountll(um) - ((t0 & 32) ? 0 : 1); }
__device__ __forceinline__ int win_tiles(int qt) { const int t0 = 32 * qt; return qt - (t0 >= 512 ? (t0 - 512) >> 5 : 0) + 1; }
__device__ __forceinline__ int cmp_tiles(int qt) { const int tmax = 32 * qt + 31; int ncm = tmax >= 31 ? ((tmax - 31) >> 4) + 1 : 0; ncm = ncm > 255 ? 255 : ncm; return (ncm + 31) >> 5; }
__device__ __forceinline__ unsigned long long tile_union(unsigned long long mask) {
    unsigned ulo = (unsigned)mask, uhi = (unsigned)(mask >> 32);
    ulo |= (unsigned)lx_i<1>((int)ulo); uhi |= (unsigned)lx_i<1>((int)uhi); ulo |= (unsigned)lx_i<2>((int)ulo); uhi |= (unsigned)lx_i<2>((int)uhi); ulo |= (unsigned)lx_i<4>((int)ulo); uhi |= (unsigned)lx_i<4>((int)uhi);
    ulo |= (unsigned)lx_i<8>((int)ulo); uhi |= (unsigned)lx_i<8>((int)uhi); ulo |= (unsigned)lx_i<16>((int)ulo); uhi |= (unsigned)lx_i<16>((int)uhi);
    return (unsigned long long)(unsigned)__builtin_amdgcn_readfirstlane((int)ulo) | ((unsigned long long)(unsigned)__builtin_amdgcn_readfirstlane((int)uhi) << 32); }
__device__ __forceinline__ void nsa_quad_item(const bf16* PROJ, const bf16* KC, const unsigned char* VCB, const unsigned char* VTB, const unsigned long long* SEL, bf16* O, LAS unsigned char* lds, int bg, int jp, int wave) {
    const int lane = fresh_lane();
    const int b = bg >> 1, g = bg & 1, wi = wave & 3, qd = wave >> 2, hd = 4 * g + wi, qt = 2 * jp + qd, qto = 2 * jp + (qd ^ 1), q = lane & 31, hh = lane >> 5, t0 = qt * 32, tq = t0 + q, tmax = t0 + 31;
    LAS unsigned char* ring = lds + qd * 65536;
#define NSA_ROW() ((size_t)b * SEQ + t0 + (fresh_lane() & 31))
    const float slope2 = __builtin_amdgcn_exp2f(-(float)(hd + 1)) * LOG2E;
    bf16x8 qf[4]; load_qfrag(PROJ + NSA_ROW() * NINP + C_NSAQ + hd * 64 + 8 * hh, qf);
    f32x16 o[2]; unsigned res[16];
    {
        const unsigned long long mask = SEL[(size_t)(b * 2 + g) * SEQ + tq], masko = SEL[(size_t)(b * 2 + g) * SEQ + 32 * qto + q];
        const unsigned long long um = tile_union(mask), umo = tile_union(masko);
        const int n_own = slc_tiles(um, t0), n_oth = slc_tiles(umo, 32 * qto);
        SlcBias f; f.setup(slope2, hh); f.tq = tq;
        QuadStream st; st.setup(PROJ + (size_t)b * SEQ * NINP + C_SLCK + g * 64, (size_t)NINP * 2, VTB + vtb_off(b, 7 + g, 0), lane, wi);
        zero_ot<2>(o); float m = NEG_BIG, l = 0.f;
        SlcIt it; it.um = um; it.pend = -1; it.tmax = tmax; SlcPre pre{f, mask, t0};
        quad_stream(qf, st, ring, f, it, it, pre, n_own, n_own > n_oth ? n_own : n_oth, hh, o, m, l);
        l = half_sum(l); const float g1 = sigmoidf_(bf2f(PROJ[NSA_ROW() * NINP + C_GATE + hd * 3 + 1])); const float w = l > 0.f ? g1 / l : 0.f;
#pragma unroll
        for (int dt = 0; dt < 2; ++dt)
#pragma unroll
            for (int r = 0; r < 16; r += 2) res[dt * 8 + (r >> 1)] = cvtpk(o[dt][r] * w, o[dt][r + 1] * w);
    }
    {
        WinBias f; f.setup(slope2, hh); f.tq = tq; f.t0 = t0;
        QuadStream st; st.setup(PROJ + (size_t)b * SEQ * NINP + C_WINK + g * 64, (size_t)NINP * 2, VTB + vtb_off(b, 9 + g, 0), lane, wi);
        zero_ot<2>(o); float m = NEG_BIG, l = 0.f;
        RangeIt it; it.kt = qt; it.kt0 = t0 >= 512 ? (t0 - 512) >> 5 : 0; RangePre<WinBias> pre{f};
        const int n_own = win_tiles(qt), n_oth = win_tiles(qto);
        quad_stream(qf, st, ring, f, it, it, pre, n_own, n_own > n_oth ? n_own : n_oth, hh, o, m, l);
        l = half_sum(l); const float g2 = sigmoidf_(bf2f(PROJ[NSA_ROW() * NINP + C_GATE + hd * 3 + 2])); const float w = l > 0.f ? g2 / l : 0.f;
#pragma unroll
        for (int dt = 0; dt < 2; ++dt)
#pragma unroll
            for (int r = 0; r < 16; r += 2) { const unsigned pr = res[dt * 8 + (r >> 1)]; res[dt * 8 + (r >> 1)] = cvtpk(fmaf(o[dt][r], w, lo16(pr)), fmaf(o[dt][r + 1], w, hi16(pr))); }
    }
    {
        CmpBias f; f.setup(16.f * slope2, hh); f.tq = tq; f.ncv = tq >= 31 ? ((tq - 31) >> 4) + 1 : 0; f.ncv = f.ncv > 255 ? 255 : f.ncv;
        f.ncv_min = t0 >= 31 ? ((t0 - 31) >> 4) + 1 : 0; f.ncv_min = f.ncv_min > 255 ? 255 : f.ncv_min;
        QuadStream st; st.setup(KC + (size_t)((0 * BATCH + b) * 2 + g) * 256 * 64, 128, VCB + (size_t)(b * 2 + g) * 8 * 4096, lane, wi);
        zero_ot<2>(o); float m = NEG_BIG, l = 0.f;
        const int n_own = cmp_tiles(qt), n_oth = cmp_tiles(qto);
        RangeIt it; it.kt = n_own - 1; it.kt0 = 0; RangePre<CmpBias> pre{f};
        quad_stream(qf, st, ring, f, it, it, pre, n_own, n_own > n_oth ? n_own : n_oth, hh, o, m, l);
        l = half_sum(l); const float g0 = sigmoidf_(bf2f(PROJ[NSA_ROW() * NINP + C_GATE + hd * 3 + 0])); const float w = l > 0.f ? g0 / l : 0.f;
#pragma unroll
        for (int dt = 0; dt < 2; ++dt)
#pragma unroll
            for (int r = 0; r < 16; r += 2) { const unsigned pr = res[dt * 8 + (r >> 1)]; o[dt][r] = fmaf(o[dt][r], w, lo16(pr)); o[dt][r + 1] = fmaf(o[dt][r + 1], w, hi16(pr)); }
    }
    store_ot<2>(O + NSA_ROW() * DM + O_NSA + hd * 64, o, 1.f, fresh_lane() >> 5);
#undef NSA_ROW
    asm volatile("s_waitcnt vmcnt(0) lgkmcnt(0)" ::: "memory"); __builtin_amdgcn_s_barrier(); asm volatile("" ::: "memory");
}
__device__ __forceinline__ void dil_item_mfma(const bf16* PROJ, const unsigned char* VTB, bf16* O, LAS unsigned char* ring  , int bj, int r16, int qt8, int lane) {
    lane = fresh_lane();
    const int b = bj / 3, j = bj % 3, q = lane & 31, hh = lane >> 5, i16 = qt8 * 32 + q, tq = r16 + 16 * i16; const size_t row = (size_t)b * SEQ + tq;
    f32x16 o[3][2]; float m[3], l[3];
#pragma unroll
    for (int g = 0; g < 3; ++g) { const int head = 3 * g + j, d = g == 0 ? 1 : (g == 1 ? 4 : 16), seg = SEQ / d, rd = r16 % d;
        DilBias f; f.setup(__builtin_amdgcn_exp2f(-8.f * (float)(head + 1) / 9.f) * LOG2E * (float)d, hh); f.iq = tq / d;
        const int imin = (r16 + 16 * (qt8 * 32)) / d, imax = (r16 + 16 * (qt8 * 32 + 31)) / d;
        const int kt0 = imin >= 128 ? (imin - 128) >> 5 : 0, kt1 = imax >> 5;
        bf16x8 qf[4]; load_qfrag(PROJ + row * NINP + C_DILQ + head * 64 + 8 * hh, qf);
        WvStream st; st.setup(PROJ + ((size_t)b * SEQ + rd) * NINP + C_DILK + head * 64, (size_t)d * NINP * 2, VTB + vtb_off(b, 11 + head, rd * (seg >> 5)), lane);
        zero_ot<2>(o[g]); m[g] = NEG_BIG; l[g] = 0.f;
        RangeIt it; it.kt = kt1; it.kt0 = kt0; RangePre<DilBias> pre{f};
        att_stream<2>(qf, st, ring, f, it, pre, hh, o[g], m[g], l[g]);
        l[g] = half_sum(l[g]);
    }
    const float mx = fmaxf(m[0], fmaxf(m[1], m[2]));
    const float e0 = __builtin_amdgcn_exp2f(m[0] - mx), e1 = __builtin_amdgcn_exp2f(m[1] - mx), e2 = __builtin_amdgcn_exp2f(m[2] - mx);
    const float inv = 1.f / (l[0] * e0 + l[1] * e1 + l[2] * e2);
    store_ot<2>(O + row * DM + O_DIL + (0 + j) * 64, o[0], e0 * inv, hh);
    store_ot<2>(O + row * DM + O_DIL + (3 + j) * 64, o[1], e1 * inv, hh);
    store_ot<2>(O + row * DM + O_DIL + (6 + j) * 64, o[2], e2 * inv, hh);
}
__device__ __forceinline__ void compress_item_mfma(const bf16* PROJ, const bf16* W1T, const bf16* W2T, const float* PW1, bf16* KC, unsigned char* VCB, int it, LAS unsigned char* lds, int wave, int lane) {
    const int kv = it >> 5, b = (it >> 4) & 1, g = (it >> 3) & 1, ct = it & 7, cl = lane & 31, hh = lane >> 5;
    const int colbase = (kv ? C_CMPV : C_CMPK) + g * 64, tokbase = 16 * (32 * ct + cl);
    const bf16* w1t = W1T + (size_t)kv * 64 * 2048 + (size_t)cl * 2048 + 8 * hh;
    f32x16 hT[2]; zero_ot<2>(hT);
#pragma unroll 4
    for (int s = 16 * wave; s < 16 * wave + 16; ++s) { int tok = tokbase + (s >> 2); tok = tok < SEQ ? tok : SEQ - 1;
        const bf16x8 bfr = *(const GAS bf16x8*)(PROJ + ((size_t)b * SEQ + tok) * NINP + colbase + 16 * (s & 3) + 8 * hh);
        const bf16x8 a0 = *(const GAS bf16x8*)(w1t + 16 * s), a1 = *(const GAS bf16x8*)(w1t + (size_t)32 * 2048 + 16 * s);
        hT[0] = MFMA32(a0, bfr, hT[0]); hT[1] = MFMA32(a1, bfr, hT[1]); }
    LAS float* part = (LAS float*)lds;
#pragma unroll
    for (int nt = 0; nt < 2; ++nt)
#pragma unroll
        for (int r = 0; r < 16; ++r) part[(wave * 32 + nt * 16 + r) * 64 + lane] = hT[nt][r];
    __syncthreads();
    if (wave == 0) {
#pragma unroll 1
        for (int w = 1; w < 8; ++w) { const LAS float* pw = part + (size_t)(w * 32) * 64 + lane;
#pragma unroll
            for (int nt = 0; nt < 2; ++nt)
#pragma unroll
                for (int r = 0; r < 16; ++r) hT[nt][r] += pw[(nt * 16 + r) * 64]; }
        bf16x8 xf[2][2];
#pragma unroll
        for (int nt = 0; nt < 2; ++nt) {
#pragma unroll
            for (int g4 = 0; g4 < 4; ++g4) { const f32x4 pb = *(const f32x4*)(PW1 + kv * 64 + 32 * nt + 8 * g4 + 4 * hh);
                hT[nt][4 * g4] = gelu_tanh(hT[nt][4 * g4] + pb.x); hT[nt][4 * g4 + 1] = gelu_tanh(hT[nt][4 * g4 + 1] + pb.y); hT[nt][4 * g4 + 2] = gelu_tanh(hT[nt][4 * g4 + 2] + pb.z); hT[nt][4 * g4 + 3] = gelu_tanh(hT[nt][4 * g4 + 3] + pb.w); }
#pragma unroll
            for (int s2 = 0; s2 < 2; ++s2) { v4u p; p.x = cvtpk(hT[nt][8 * s2], hT[nt][8 * s2 + 1]); p.y = cvtpk(hT[nt][8 * s2 + 2], hT[nt][8 * s2 + 3]); p.z = cvtpk(hT[nt][8 * s2 + 4], hT[nt][8 * s2 + 5]); p.w = cvtpk(hT[nt][8 * s2 + 6], hT[nt][8 * s2 + 7]);
                xf[nt][s2] = __builtin_bit_cast(bf16x8, p); } }
        f32x16 oT[2]; zero_ot<2>(oT);
#pragma unroll
        for (int n2t = 0; n2t < 2; ++n2t)
#pragma unroll
            for (int nt = 0; nt < 2; ++nt)
#pragma unroll
                for (int s2 = 0; s2 < 2; ++s2) { const bf16* wp = W2T + (size_t)kv * 64 * 64 + (size_t)(32 * n2t + cl) * 64 + 32 * nt + 16 * s2 + 4 * hh;
                    const v2u lo = *(const v2u*)wp, hi = *(const v2u*)(wp + 8); v4u a; a.x = lo.x; a.y = lo.y; a.z = hi.x; a.w = hi.y;
                    oT[n2t] = MFMA32(__builtin_bit_cast(bf16x8, a), xf[nt][s2], oT[n2t]); }
        if (kv == 0) store_ot<2>(KC + ((size_t)((0 * BATCH + b) * 2 + g) * 256 + 32 * ct + cl) * 64, oT, 1.f, hh);
        else { bf16* vb = (bf16*)(VCB + (size_t)((b * 2 + g) * 8 + ct) * 4096) + vtb_pos_of_key(cl);
#pragma unroll
            for (int n2t = 0; n2t < 2; ++n2t)
#pragma unroll
                for (int r = 0; r < 16; ++r) vb[n2t * 1024 + ((r & 3) + 8 * (r >> 2) + 4 * hh) * 32] = (bf16)(cvtpk(oT[n2t][r], 0.f) & 0xffffu); }
    }
    __syncthreads();
}
__device__ __forceinline__ void pre_attn(const bf16* PROJ, const float* fbias, unsigned char* ws, int layer, LAS unsigned char* lds, int bid, int G, int gw, int NGW, int wave, int lane) {
    const int bstride = G >= 64 ? G / 64 : 1;
    for (int it = bid / bstride; it < 64 && bid % bstride == 0; it += G / bstride)
        compress_item_mfma(PROJ, (const bf16*)(ws + WS_W1T) + (size_t)layer * 2 * 64 * 2048, (const bf16*)(ws + WS_W2T) + (size_t)layer * 2 * 64 * 64, (const float*)(ws + WS_PW1) + layer * 2 * 64,
                           (bf16*)(ws + WS_KC), ws + WS_VCB, it, lds, wave, lane);
    for (int ci = (bid - 1) / bstride; ci < BATCH * 7 && bid >= 1 && (bid - 1) % bstride == 0; ci += G / bstride)
        fox_cum_block(PROJ, fbias, (float*)(ws + WS_CUM), ci, lds, wave, lane);
    if (bstride == 4 && G % 4 == 0 && G >= 64) { const bool cum = bid % 4 == 1 && (bid - 1) / 4 < BATCH * 7;
        if (bid % 4 != 0 && !cum) { int ncum = (bid + 2) / 4; ncum = ncum > BATCH * 7 ? BATCH * 7 : ncum;
            const int idx = (bid / 4) * 3 + (bid % 4 - 1) - ncum, nw = (G - G / 4 - BATCH * 7) * NWAVES;
            for (int it = idx * NWAVES + wave; it < BATCH * NHS * VTB_KB; it += nw) vprep_item(PROJ, ws + WS_VTB, it, (LAS unsigned*)(lds + wave * 16384), lane); } }
    else for (int it = gw; it < BATCH * NHS * VTB_KB; it += NGW) vprep_item(PROJ, ws + WS_VTB, it, (LAS unsigned*)(lds + wave * 16384), lane);
}
__device__ __forceinline__ void qk_tile(const bf16x8 (&qf)[4], const bf16* kp, f32x16& s) {
#pragma unroll
    for (int r = 0; r < 16; ++r) s[r] = 0.f;
#pragma unroll
    for (int ks = 0; ks < 4; ++ks) { const bf16x8 kf = *(const bf16x8*)(kp + 16 * ks); s = MFMA32(kf, qf[ks], s); }
}
__device__ __forceinline__ void nsa_select_mfma(const bf16* PROJ, const bf16* KC, unsigned long long* SEL, LAS unsigned* scr  , int it, int lane) {
    const int b = it >> 8, g = (it >> 7) & 1, qt = it & 127, q = lane & 31, hh = lane >> 5, t0 = qt * 32, tq = t0 + q, tmax = t0 + 31; const size_t row = (size_t)b * SEQ + tq;
    int ncv = tq >= 31 ? ((tq - 31) >> 4) + 1 : 0; ncv = ncv > 255 ? 255 : ncv;
    int ncm = tmax >= 31 ? ((tmax - 31) >> 4) + 1 : 0; ncm = ncm > 255 ? 255 : ncm;
    const int ntile = (ncm + 31) >> 5;
    const bf16* kb = KC + ((size_t)((0 * BATCH + b) * 2 + g) * 256 + q) * 64 + 8 * hh;
    const bf16* qb = PROJ + row * NINP + C_NSAQ + (4 * g) * 64 + 8 * hh;
    float mh[4], ih[4];
#pragma unroll
    for (int jh = 0; jh < 4; ++jh) { CmpSel f; f.slope2 = __builtin_amdgcn_exp2f(-(float)(4 * g + jh + 1)) * LOG2E; f.tq = tq; f.ncv = ncv;
        bf16x8 qf[4]; load_qfrag(qb + jh * 64, qf);
        float m = NEG_BIG, l = 0.f;
#pragma unroll 1
        for (int T = 0; T < ntile; ++T) { f32x16 s; qk_tile(qf, kb + (size_t)(32 * T) * 64, s);
            float mx = NEG_BIG;
#pragma unroll
            for (int r = 0; r < 16; ++r) { s[r] = f(s[r], 32 * T + (r & 3) + 8 * (r >> 2) + 4 * hh, r); mx = fmaxf(mx, s[r]); }
            mx = half_max(mx);
            const float mn = fmaxf(m, mx); float ps = 0.f;
#pragma unroll
            for (int r = 0; r < 16; ++r) ps += __builtin_amdgcn_exp2f(s[r] - mn);
            l = fmaf(l, __builtin_amdgcn_exp2f(m - mn), ps); m = mn; }
        l = half_sum(l);
        mh[jh] = m; ih[jh] = (ncv > 0 && l > 0.f) ? 1.f / l : 0.f;
        asm volatile("" ::: "memory"); }
    const int cur = tq >> 6; float carry = 0.f;
    LAS unsigned* kq = scr + q * 65;
#pragma unroll 1
    for (int T = 0; T < 8; ++T) { f32x16 acc;
#pragma unroll
        for (int r = 0; r < 16; ++r) acc[r] = 0.f;
        if (T < ntile) {
#pragma unroll
            for (int jh = 0; jh < 4; ++jh) { CmpSel f; f.slope2 = __builtin_amdgcn_exp2f(-(float)(4 * g + jh + 1)) * LOG2E; f.tq = tq; f.ncv = ncv;
                bf16x8 qf[4]; load_qfrag(qb + jh * 64, qf); f32x16 s; qk_tile(qf, kb + (size_t)(32 * T) * 64, s);
#pragma unroll
                for (int r = 0; r < 16; ++r) acc[r] = fmaf(__builtin_amdgcn_exp2f(f(s[r], 32 * T + (r & 3) + 8 * (r >> 2) + 4 * hh, r) - mh[jh]), ih[jh], acc[r]);
                asm volatile("" ::: "memory"); } }
        float x3[4];
#pragma unroll
        for (int g4 = 0; g4 < 4; ++g4) x3[g4] = half_other(acc[4 * g4 + 3], hh);
#pragma unroll
        for (int g4 = 0; g4 < 4; ++g4) { const int idx = 4 * T + g4, j = 2 * idx + hh;
            const float prev3 = hh ? x3[g4] : (g4 > 0 ? x3[g4 - 1] : carry);
            const float imp = prev3 + 2.f * (acc[4 * g4] + acc[4 * g4 + 1] + acc[4 * g4 + 2]) + acc[4 * g4 + 3];
            const bool causal = 64 * j <= tq, forced = j == 0 || j == cur || j == cur - 1;
            const float scv = causal ? (forced ? 1e4f : imp) : 0.f;
            kq[j] = (__builtin_bit_cast(unsigned, scv) & ~63u) | (unsigned)(63 - j); }
        carry = x3[3]; }
    LDS_WAIT(); asm volatile("" ::: "memory");
    unsigned key[32];
#pragma unroll
    for (int idx = 0; idx < 32; ++idx) key[idx] = kq[2 * idx + hh];
    int rank[32];
#pragma unroll
    for (int idx = 0; idx < 32; ++idx) rank[idx] = 0;
#pragma unroll 2
    for (int jj = 0; jj < 64; ++jj) { const unsigned kv = kq[jj];
#pragma unroll
        for (int idx = 0; idx < 32; ++idx) rank[idx] += kv > key[idx] ? 1 : 0; }
    LDS_WAIT(); asm volatile("" ::: "memory");
    unsigned mlo = 0u, mhi = 0u;
#pragma unroll
    for (int idx = 0; idx < 32; ++idx) { const bool sel = rank[idx] < 16 && 64 * (2 * idx + hh) <= tq;
        const unsigned bit = sel ? (1u << ((2 * idx) & 31)) << hh : 0u;
        if (idx < 16) mlo |= bit; else mhi |= bit; }
    mlo = half_or(mlo); mhi = half_or(mhi);
    if (hh == 0) SEL[(size_t)(b * 2 + g) * SEQ + tq] = (unsigned long long)mlo | ((unsigned long long)mhi << 32);
}
__device__ __forceinline__ void qk_tile_lds(const bf16x8 (&qf)[4], const LAS unsigned char* kt, int fk, f32x16& s) {
    bf16x8 kf[4];
#pragma unroll
    for (int ks = 0; ks < 4; ++ks) kf[ks] = *(const LAS bf16x8*)(kt + (fk ^ (ks << 5)));
#pragma unroll
    for (int r = 0; r < 16; ++r) s[r] = 0.f;
#pragma unroll
    for (int ks = 0; ks < 4; ++ks) s = MFMA32(kf[ks], qf[ks], s);
}
__device__ __forceinline__ void nsa_select_coop(const bf16* PROJ, const bf16* KC, unsigned long long* SEL, LAS unsigned char* lds, int pair, int tid) {
    const int wave = tid >> 6, lane = tid & 63, sub = wave >> 2, jh = wave & 3, it = 2 * pair + sub;
    const int b = it >> 8, g = (it >> 7) & 1, qt = it & 127, q = lane & 31, hh = lane >> 5, t0 = qt * 32, tq = t0 + q, tmax = t0 + 31; const size_t row = (size_t)b * SEQ + tq;
    int ncv = tq >= 31 ? ((tq - 31) >> 4) + 1 : 0; ncv = ncv > 255 ? 255 : ncv;
    int ncm = tmax >= 31 ? ((tmax - 31) >> 4) + 1 : 0; ncm = ncm > 255 ? 255 : ncm;
    const int ntile = (ncm + 31) >> 5;
    LAS float* impb = (LAS float*)(lds + sub * 49152);
    LAS unsigned* kq = (LAS unsigned*)(lds + sub * 49152 + 33280) + q * 65;
    LAS unsigned* mk = (LAS unsigned*)(lds + sub * 49152 + 41600) + q * 2;
    LAS unsigned char* kl = lds + 98304;
    {   const int tmx = 32 * ((2 * pair + 1) & 127) + 31; int nc = tmx >= 31 ? ((tmx - 31) >> 4) + 1 : 0; nc = nc > 255 ? 255 : nc; const int nrow = 32 * ((nc + 31) >> 5);
        const GAS v4u* src = (const GAS v4u*)(KC + (size_t)((0 * BATCH + b) * 2 + g) * 256 * 64);
        for (int i = tid; i < nrow * 8; i += NWAVES * 64) { const int rw = i >> 3, c = i & 7; *(LAS v4u*)(kl + rw * 128 + ((c ^ ((rw >> 1) & 7)) << 4)) = src[i]; } }
    const int fk = q * 128 + ((hh ^ ((q >> 1) & 7)) << 4);
    CmpSel f; f.slope2 = __builtin_amdgcn_exp2f(-(float)(4 * g + jh + 1)) * LOG2E; f.tq = tq; f.ncv = ncv;
    bf16x8 qf[4]; load_qfrag(PROJ + row * NINP + C_NSAQ + (4 * g + jh) * 64 + 8 * hh, qf);
    __syncthreads();
    float m = NEG_BIG, l = 0.f;
#pragma unroll 1
    for (int T = 0; T < ntile; ++T) { f32x16 s; qk_tile_lds(qf, kl + T * 4096, fk, s);
        float mx = NEG_BIG;
#pragma unroll
        for (int r = 0; r < 16; ++r) { s[r] = f(s[r], 32 * T + (r & 3) + 8 * (r >> 2) + 4 * hh, r); mx = fmaxf(mx, s[r]); }
        mx = half_max(mx);
        const float mn = fmaxf(m, mx); float ps = 0.f;
#pragma unroll
        for (int r = 0; r < 16; ++r) ps += __builtin_amdgcn_exp2f(s[r] - mn);
        l = fmaf(l, __builtin_amdgcn_exp2f(m - mn), ps); m = mn; }
    l = half_sum(l);
    const float inv = (ncv > 0 && l > 0.f) ? 1.f / l : 0.f;
    if (lane < 32 && jh == 0) { unsigned z = 0u; asm volatile("" : "+v"(z)); mk[0] = z; mk[1] = z; }
    float carry = 0.f;
    LAS float* ib = impb + (jh * 32 + q) * 65;
#pragma unroll 1
    for (int T = 0; T < 8; ++T) { f32x16 acc;
#pragma unroll
        for (int r = 0; r < 16; ++r) acc[r] = 0.f;
        if (T < ntile) { f32x16 s; qk_tile_lds(qf, kl + T * 4096, fk, s);
#pragma unroll
            for (int r = 0; r < 16; ++r) acc[r] = __builtin_amdgcn_exp2f(f(s[r], 32 * T + (r & 3) + 8 * (r >> 2) + 4 * hh, r) - m) * inv; }
        float x3[4];
#pragma unroll
        for (int g4 = 0; g4 < 4; ++g4) x3[g4] = half_other(acc[4 * g4 + 3], hh);
#pragma unroll
        for (int g4 = 0; g4 < 4; ++g4) { const int j = 2 * (4 * T + g4) + hh;
            const float prev3 = hh ? x3[g4] : (g4 > 0 ? x3[g4 - 1] : carry);
            ib[j] = prev3 + 2.f * (acc[4 * g4] + acc[4 * g4 + 1] + acc[4 * g4 + 2]) + acc[4 * g4 + 3]; }
        carry = x3[3]; }
    __syncthreads();
    const int cur = tq >> 6;
#pragma unroll
    for (int i = 0; i < 8; ++i) { const int j = 2 * (8 * jh + i) + hh; const LAS float* p = impb + q * 65 + j;
        const float imp = ((p[0] + p[32 * 65]) + p[2 * 32 * 65]) + p[3 * 32 * 65];
        const bool causal = 64 * j <= tq, forced = j == 0 || j == cur || j == cur - 1;
        const float scv = causal ? (forced ? 1e4f : imp) : 0.f;
        kq[j] = (__builtin_bit_cast(unsigned, scv) & ~63u) | (unsigned)(63 - j); }
    __syncthreads();
    unsigned key[8]; int rank[8];
#pragma unroll
    for (int i = 0; i < 8; ++i) { key[i] = kq[2 * (8 * jh + i) + hh]; rank[i] = 0; }
#pragma unroll 4
    for (int jj = 0; jj < 64; ++jj) { const unsigned kv = kq[jj];
#pragma unroll
        for (int i = 0; i < 8; ++i) rank[i] += kv > key[i] ? 1 : 0; }
    unsigned bits = 0u;
#pragma unroll
    for (int i = 0; i < 8; ++i) { const int j = 2 * (8 * jh + i) + hh; if (rank[i] < 16 && 64 * j <= tq) bits |= 1u << (j & 31); }
    if (bits) __hip_atomic_fetch_or(mk + (jh >> 1), bits, __ATOMIC_RELAXED, __HIP_MEMORY_SCOPE_WORKGROUP);
    __syncthreads();
    if (jh == 0 && hh == 0) SEL[(size_t)(b * 2 + g) * SEQ + tq] = (unsigned long long)mk[0] | ((unsigned long long)mk[1] << 32);
    __syncthreads();
}
template <int NDT, class F>
__device__ __forceinline__ void coop_step(const bf16x8 (&qf)[4], const LAS unsigned char* buf, int fk, int fv, int vsub  , F& f, int st, int t0_mine, int hh, f32x16 (&o)[NDT], float& m, float& l) {
    const int k0 = 64 * st, k1 = k0 + 32;
    if (k0 > t0_mine) return;
    bf16x8 pf0, pf1;
    if (k1 <= t0_mine) {
        f32x16 sA, sB;
#pragma unroll
        for (int ks = 0; ks < 4; ++ks) { const bf16x8 kf = *(const LAS bf16x8*)(buf + 4096 + (fk ^ (ks << 5))); sA = MFMA32(kf, qf[ks], ks == 0 ? f.c1() : sA); }
        if (NDT == 2) {
#pragma unroll
            for (int ks = 0; ks < 4; ++ks) { const bf16x8 kf = *(const LAS bf16x8*)(buf + (fk ^ (ks << 5))); sB = MFMA32(kf, qf[ks], ks == 0 ? f.c0() : sB); }
            if (st > 0) f.fetch2(st - 1);
            __builtin_amdgcn_sched_barrier(0); }
        f.begin(k1); softmax_body<NDT>(sA, f, k1, hh, o, m, l, pf0, pf1, k1 == t0_mine ? 1 : 0);
#pragma unroll
        for (int dt = 0; dt < NDT; ++dt) { const bf16x8 vf0 = *(const LAS bf16x8*)(buf + 4096 + dt * 2048 + fv + vsub), vf1 = *(const LAS bf16x8*)(buf + 4096 + dt * 2048 + ((fv + vsub) ^ 32));
            o[dt] = MFMA32(vf0, pf0, o[dt]); o[dt] = MFMA32(vf1, pf1, o[dt]); }
        if (NDT != 2) {
#pragma unroll
            for (int ks = 0; ks < 4; ++ks) { const bf16x8 kf = *(const LAS bf16x8*)(buf + (fk ^ (ks << 5))); sB = MFMA32(kf, qf[ks], ks == 0 ? f.c0() : sB); }
            if (st > 0) f.fetch2(st - 1); }
        f.begin(k0); softmax_body<NDT>(sB, f, k0, hh, o, m, l, pf0, pf1, 0);
#pragma unroll
        for (int dt = 0; dt < NDT; ++dt) { const bf16x8 vf0 = *(const LAS bf16x8*)(buf + dt * 2048 + fv), vf1 = *(const LAS bf16x8*)(buf + dt * 2048 + (fv ^ 32));
            o[dt] = MFMA32(vf0, pf0, o[dt]); o[dt] = MFMA32(vf1, pf1, o[dt]); }
    } else {
        f32x16 sB;
#pragma unroll
        for (int ks = 0; ks < 4; ++ks) { const bf16x8 kf = *(const LAS bf16x8*)(buf + (fk ^ (ks << 5))); sB = MFMA32(kf, qf[ks], ks == 0 ? f.c0() : sB); }
        if (st > 0) f.fetch2(st - 1);
        f.begin(k0); softmax_body<NDT>(sB, f, k0, hh, o, m, l, pf0, pf1, 1);
#pragma unroll
        for (int dt = 0; dt < NDT; ++dt) { const bf16x8 vf0 = *(const LAS bf16x8*)(buf + dt * 2048 + fv), vf1 = *(const LAS bf16x8*)(buf + dt * 2048 + (fv ^ 32));
            o[dt] = MFMA32(vf0, pf0, o[dt]); o[dt] = MFMA32(vf1, pf1, o[dt]); }
    }
}
template <int NDT, int NMAP> struct CoopGeom { static constexpr int KB = NMAP * 8192, VS = NDT * 2048, TB = KB + 2 * VS; };
template <int NDT, int NMAP, class F>
__device__ __forceinline__ void coop_pass(const bf16x8 (&qf)[4], const bf16* kcol0, const bf16* kcol1, const unsigned char* vtb0, const unsigned char* vtb1, F& f, int step_last, int t0_mine, int mapsel,
                                          LAS unsigned char* sbuf, int tid, int hh, f32x16 (&o)[NDT], float& m, float& l) {
    typedef CoopGeom<NDT, NMAP> Gm;
    const int lane = tid & 63;
    const int skey = tid >> 3, sch = tid & 7;
    const size_t ksoff = (size_t)skey * NINP + sch * 8;
    const int kdst = skey * 128 + ((sch ^ ((skey >> 1) & 7)) << 4);
    const int w8 = tid * 16;
    const unsigned char* vsrc = (NDT == 4 ? ((w8 >= 4096 ? vtb1 : vtb0) + (w8 & 4095)) : (vtb0 + (size_t)(w8 >> 12) * 4096 + (w8 & 4095)));
    const int vdst = Gm::KB + (NDT == 4 ? ((w8 & 4096) + swz_v(w8 & 4095)) : ((w8 >> 12) * Gm::VS + swz_v(w8 & 4095)));
    const int fk = mapsel * 8192 + (lane & 31) * 128 + ((hh ^ (((lane & 31) >> 1) & 7)) << 4);
    const int fv = Gm::KB + (lane & 31) * 64 + ((hh ^ (((lane & 31) >> 2) & 3)) << 4);
    v4u kr0[2], kr1[2], vr0[2], vr1[2];
#define CP_LOAD(S, st_) do { const size_t ko = ksoff + (size_t)(64 * (st_)) * NINP; const size_t vo = (size_t)(2 * (st_)) * 4096; \
        kr0[S] = *(const GAS v4u*)(kcol0 + ko); if (NMAP == 2) kr1[S] = *(const GAS v4u*)(kcol1 + ko); \
        vr0[S] = *(const GAS v4u*)(vsrc + vo); if (NDT == 4) vr1[S] = *(const GAS v4u*)(vsrc + vo + 4096); } while (0)
#define CP_PARK(S, buf) do { *(LAS v4u*)((buf) + kdst) = kr0[S]; if (NMAP == 2) *(LAS v4u*)((buf) + 8192 + kdst) = kr1[S]; \
        *(LAS v4u*)((buf) + vdst) = vr0[S]; if (NDT == 4) *(LAS v4u*)((buf) + vdst + Gm::VS) = vr1[S]; } while (0)
#define CP_COMPUTE(st_, buf) do { if constexpr (NDT == 2) coop_step<NDT>(qf, (buf), fk, fv, Gm::VS - 4096, f, (st_), t0u, hh, o, m, l); else { \
        _Pragma("unroll") for (int sub = 1; sub >= 0; --sub) { const int k0 = 64 * (st_) + 32 * sub; \
        if (k0 <= t0_mine) { f.begin(k0); \
            if (k0 == t0_mine) att_compute_lds<NDT, true>(qf, (buf) + sub * 4096, fk, fv + sub * (Gm::VS - 4096), f, k0, hh, o, m, l); \
            else att_compute_lds<NDT, false>(qf, (buf) + sub * 4096, fk, fv + sub * (Gm::VS - 4096), f, k0, hh, o, m, l); } } } } while (0)
#define CP_BAR() do { asm volatile("s_waitcnt lgkmcnt(0)" ::: "memory"); __builtin_amdgcn_s_barrier(); asm volatile("" ::: "memory"); } while (0)
    LAS unsigned char* b0 = sbuf; LAS unsigned char* b1 = sbuf + Gm::TB;
    CP_LOAD(0, step_last); if (step_last >= 1) CP_LOAD(1, step_last - 1);
    const int t0u = __builtin_amdgcn_readfirstlane(t0_mine);
    f.fetch2(t0u >> 6);
    CP_PARK(0, b0);
    CP_BAR();
#pragma unroll 1
    for (int st = step_last; st >= 0; st -= 2) {
        if (st - 2 >= 0) CP_LOAD(0, st - 2);
        __builtin_amdgcn_sched_barrier(0);
        CP_COMPUTE(st, b0);
        if (st - 1 >= 0) CP_PARK(1, b1);
        CP_BAR();
        if (st - 1 < 0) break;
        if (st - 3 >= 0) CP_LOAD(1, st - 3);
        __builtin_amdgcn_sched_barrier(0);
        CP_COMPUTE(st - 1, b1);
        if (st - 2 >= 0) CP_PARK(0, b0);
        CP_BAR();
    }
#undef CP_LOAD
#undef CP_PARK
#undef CP_COMPUTE
#undef CP_BAR
    __syncthreads();
}
__device__ __forceinline__ void fox_coop(const bf16* PROJ, const float* CUM, const unsigned char* VTB, bf16* O, int bh, int c, LAS unsigned char* sbuf, int tid) {
    const int wave = tid >> 6, lane = tid & 63, b = bh / 7, hd = bh % 7, q = lane & 31, hh = lane >> 5, qt = 8 * c + wave, tq = 32 * qt + q; const size_t row = (size_t)b * SEQ + tq;
    bf16x8 qf[4]; load_qfrag(PROJ + row * NINP + C_FOXQ + hd * 64 + 8 * hh, qf);
    FoxBias f; f.cum2 = CUM + (size_t)(b * 7 + hd) * SEQ; f.tadd = -QK_SCL * f.cum2[tq]; f.tq = tq; f.t0 = 32 * qt; f.hh = hh;
    f32x16 o[2]; zero_ot<2>(o); float m = NEG_BIG, l = 0.f;
    const bf16* kc = PROJ + (size_t)b * SEQ * NINP + C_FOXK + hd * 64;
    coop_pass<2, 1>(qf, kc, kc, VTB + vtb_off(b, hd, 0), VTB, f, 4 * c + 3, 32 * qt, 0, sbuf, tid, hh, o, m, l);
    l = half_sum(l);
    store_ot<2>(O + row * DM + O_FOX + hd * 64, o, 1.f / l, hh);
}
__device__ __forceinline__ void dif_coop(const bf16* PROJ, const unsigned char* VTB, bf16* O, float lam, const float* subg, float oscale, int bh, int c, LAS unsigned char* sbuf, int tid) {
    const int wave = tid >> 6, lane = tid & 63, b = bh >> 2, hd = bh & 3, q = lane & 31, hh = lane >> 5, mp = wave >> 2, qt = 4 * c + (wave & 3), tq = 32 * qt + q; const size_t row = (size_t)b * SEQ + tq;
    AlibiCausal f; f.setup(__builtin_amdgcn_exp2f(-2.f * (float)(hd + 1)) * LOG2E, hh); f.tq = tq; f.t0 = 32 * qt;
    bf16x8 qf[4]; load_qfrag(PROJ + row * NINP + C_DIFQ + hd * 128 + mp * 64 + 8 * hh, qf);
    f32x16 o[4]; zero_ot<4>(o); float m = NEG_BIG, l = 0.f;
    const bf16* kc = PROJ + (size_t)b * SEQ * NINP + C_DIFK + hd * 128;
    coop_pass<4, 2>(qf, kc, kc + 64, VTB + vtb_off(b, 20 + 2 * hd, 0), VTB + vtb_off(b, 21 + 2 * hd, 0), f, (4 * c + 3) >> 1, 32 * qt, mp, sbuf, tid, hh, o, m, l);
    l = half_sum(l);
    const float sc = mp ? lam / l : 1.f / l;
    LAS float* xb = (LAS float*)(sbuf + (wave & 3) * 16384) + lane;
    if (mp) {
#pragma unroll
        for (int dt = 0; dt < 4; ++dt)
#pragma unroll
            for (int r = 0; r < 16; ++r) xb[(dt * 16 + r) * 64] = o[dt][r] * sc; }
    __syncthreads();
    if (!mp) { float ss = 0.f;
#pragma unroll
        for (int dt = 0; dt < 4; ++dt)
#pragma unroll
            for (int r = 0; r < 16; ++r) { const float v = o[dt][r] * sc - xb[(dt * 16 + r) * 64]; o[dt][r] = v; ss = fmaf(v, v, ss); }
        ss = half_sum(ss);
        const float rs = rsqrtf(ss * (1.f / 128.f) + 1e-6f) * oscale;
#pragma unroll
        for (int dt = 0; dt < 4; ++dt) {
#pragma unroll
            for (int g = 0; g < 4; ++g) { const f32x4 gg = *(const f32x4*)(subg + 32 * dt + 8 * g + 4 * hh);
                o[dt][4 * g] *= gg.x; o[dt][4 * g + 1] *= gg.y; o[dt][4 * g + 2] *= gg.z; o[dt][4 * g + 3] *= gg.w; }
            asm volatile("" ::: "memory"); }
        store_ot<4>(O + row * DM + O_DIF + hd * 128, o, rs, hh); }
    __syncthreads();
}
struct Args { const float* in[18]; float* out; unsigned char* ws; int ph_lo, ph_hi; };
#define CAS __attribute__((address_space(4)))
__device__ __forceinline__ unsigned long long karg64(int off) { return *(volatile CAS unsigned long long*)((CAS char*)__builtin_amdgcn_kernarg_segment_ptr() + off); }
__device__ __forceinline__ int karg32(int off) { return *(volatile CAS int*)((CAS char*)__builtin_amdgcn_kernarg_segment_ptr() + off); }
#define ARG_IN(i) ((const float*)karg64(8 * (i)))
#define ARG_OUT() ((float*)karg64(8 * 18))
#define ARG_WS() ((unsigned char*)karg64(8 * 19))
static_assert(sizeof(Args) == 8 * 20 + 8, "Args layout");
enum { A_X = 0, A_C, A_ADAW, A_ADAB, A_GMIX, A_GFFN, A_WIN, A_FBIAS, A_W1, A_W2, A_POS, A_LAM, A_SUBG, A_WOUT, A_WGATE, A_WUP, A_WDOWN, A_GFINAL };
#define WSP(T, off) ((T*)(ws + (off)))
constexpr int CW_XQ = 32768;
#define XQ_HEAD(cls, q) ((gu32*)(ARG_WS() + WS_CTL) + CW_XQ + ((((layer) * 5 + (cls)) * 8 + (q)) * 2 + rep) * 16)
#ifndef PROBE_KEEP
#define PROBE_KEEP 31
#endif
#define PK(bit) (rep == 0 || (PROBE_KEEP & (bit)))
template <int ATTM> __device__ __forceinline__ void attention_phase(int layer, int lane, int rep, LAS unsigned char* lds, int wave) {
    asm volatile("" : "+s"(wave));
#define WG_DRAW(cls, q) LAS int* slot = (LAS int*)(lds + MISC_OFF + 64); \
        if (threadIdx.x == 0) *slot = (int)__hip_atomic_fetch_add(XQ_HEAD(cls, q), 1u, RLX_AGENT); \
        __syncthreads(); const int it = *slot; __syncthreads();
    if ((ATTM & 2) && PK(2)) {
#pragma unroll 1
        for (int qq = 0; qq < 8; ++qq) { const int q = ((int)(xb_xcc_id() & 7u) + qq) & 7;
            for (;;) { WG_DRAW(0, q); if (it >= 32) break;
                unsigned char* ws = ARG_WS(); int tid = threadIdx.x; asm volatile("" : "+v"(tid));
                const float* lamv = ARG_IN(A_LAM) + (size_t)layer * 4 * 64;
                const float lam_init = 0.8f - 0.6f * __builtin_amdgcn_exp2f(-0.3f * 1.4426950408889634f * (float)layer);
                const float sa = wave_sum(lamv[lane] * lamv[64 + lane]), sb = wave_sum(lamv[128 + lane] * lamv[192 + lane]);
                const float lam = __builtin_amdgcn_exp2f(1.4426950408889634f * sa) - __builtin_amdgcn_exp2f(1.4426950408889634f * sb) + lam_init;
                dif_coop(WSP(bf16, WS_PROJ), ws + WS_VTB, WSP(bf16, WS_O), lam, ARG_IN(A_SUBG) + (size_t)layer * 128, 1.f - lam_init, q, 31 - it, lds, tid); } } }
    if ((ATTM & 1) && PK(1)) {
#pragma unroll 1
        for (int qq = 0; qq < 8; ++qq) { const int q = ((int)(xb_xcc_id() & 7u) + qq) & 7; const int two = q + 8 < BATCH * 7 ? 1 : 0;
            for (;;) { WG_DRAW(1, q); if (it >= (two ? 32 : 16)) break;
                unsigned char* ws = ARG_WS(); int tid = threadIdx.x; asm volatile("" : "+v"(tid));
                const int bh = two ? ((it & 1) ? q + 8 : q) : q, c = 15 - (two ? (it >> 1) : it);
                fox_coop(WSP(bf16, WS_PROJ), WSP(float, WS_CUM), ws + WS_VTB, WSP(bf16, WS_O), bh, c, lds, tid); } } }
    if ((ATTM & 4) && PK(4)) {
#pragma unroll 1
        for (int qq = 0; qq < 8; ++qq) { const int q = ((int)(xb_xcc_id() & 7u) + qq) & 7;
            for (;;) { WG_DRAW(2, q); if (it >= 32) break; unsigned char* ws = ARG_WS();
                nsa_quad_item(WSP(bf16, WS_PROJ), WSP(bf16, WS_KC), ws + WS_VCB, ws + WS_VTB, WSP(unsigned long long, WS_SEL), WSP(bf16, WS_O), lds, q >> 1, 2 * (31 - it) + (q & 1), wave); } } }
#undef WG_DRAW
#define WV_DRAW(cls, q, n) int it = 0; if (__builtin_amdgcn_mbcnt_hi(~0u, __builtin_amdgcn_mbcnt_lo(~0u, 0u)) == 0u) it = (int)__hip_atomic_fetch_add(XQ_HEAD(cls, q), (unsigned)(n), RLX_AGENT); it = __builtin_amdgcn_readfirstlane(it);
    if ((ATTM & 8) && PK(8)) {
#pragma unroll 1
        for (int qq = 0; qq < 8; ++qq) { const int q = ((int)(xb_xcc_id() & 7u) + qq) & 7;
            for (;;) { WV_DRAW(3, q, 1); if (it >= 96) break; unsigned char* ws = ARG_WS();
                const int chunk = 3 * q + it / 32, idx = (chunk & 3) * 32 + (it & 31);
                dil_item_mfma(WSP(bf16, WS_PROJ), ws + WS_VTB, WSP(bf16, WS_O), lds + wave * 16384, chunk >> 2, idx & 15, idx >> 4, lane); } } }
    if (!(ATTM & 32) && PK(16) && layer + 1 < DEPTH) {
#pragma unroll 1
        for (int qq = 0; qq < 8; ++qq) { const int q = ((int)(xb_xcc_id() & 7u) + qq) & 7;
            for (;;) { WV_DRAW(4, q, 4); if (it >= I_LAYER / 8) break; unsigned char* ws = ARG_WS();
#pragma unroll 1
                for (int k = it; k < it + 4 && k < I_LAYER / 8; ++k) conv_item(ARG_IN(A_WIN), ARG_IN(A_WOUT), ARG_IN(A_WGATE), ARG_IN(A_WUP), ARG_IN(A_WDOWN), ws, layer + 1, q * (I_LAYER / 8) + k, lds + wave * 16384, fresh_lane()); } } }
    if (!(ATTM & 32) && PK(16) && layer == 0) {
        constexpr int I_REST = I_GU + I_D; static_assert(I_REST % 8 == 0, "");
#pragma unroll 1
        for (int qq = 0; qq < 8; ++qq) { const int q = ((int)(xb_xcc_id() & 7u) + qq) & 7;
            for (;;) { int it = 0; if (__builtin_amdgcn_mbcnt_hi(~0u, __builtin_amdgcn_mbcnt_lo(~0u, 0u)) == 0u) it = (int)__hip_atomic_fetch_add((gu32*)(ARG_WS() + WS_CTL) + CW_XQ + (((DEPTH * 5 + 4) * 8 + q) * 2 + rep) * 16, 4u, RLX_AGENT);
                it = __builtin_amdgcn_readfirstlane(it); if (it >= I_REST / 8) break; unsigned char* ws = ARG_WS();
#pragma unroll 1
                for (int k = it; k < it + 4 && k < I_REST / 8; ++k) conv_item(ARG_IN(A_WIN), ARG_IN(A_WOUT), ARG_IN(A_WGATE), ARG_IN(A_WUP), ARG_IN(A_WDOWN), ws, 0, I_IN + I_OUT + q * (I_REST / 8) + k, lds + wave * 16384, fresh_lane()); } } }
#undef WV_DRAW
}
static_assert(I_LAYER % 8 == 0, "conversion items split evenly over the 8 queues");
template <int PHM, int ATTM> __global__ void __launch_bounds__(NWAVES * 64, 2) fwd_kernel(Args args) {
    extern __shared__ __attribute__((aligned(16))) unsigned char lds_raw[];
    LAS unsigned char* lds = (LAS unsigned char*)lds_raw;
    for (int u = threadIdx.x; u < (LDS_BYTES - LDSCTL_OFF) / 4; u += NWAVES * 64) ((LAS unsigned*)(lds + LDSCTL_OFF))[u] = 0u;
    __syncthreads();
    XcdBarrier bar; bar.bar = nullptr; bar.x = 0; bar.st = nullptr;
    if (N_LAUNCH_MODE == 0) bar = xcd_barrier_post((unsigned*)(ARG_WS() + WS_CTL) + CW_BAR, (volatile LAS unsigned*)(lds + MISC_OFF) + 8);
    const int lo = karg32(8 * 20), hi = karg32(8 * 20 + 4);
#define IN(k) (lo <= (k) && (k) < hi)
#ifndef DUP_PHASE
#define DUP_PHASE -1
#endif
#define REP(k) for (int rep_ = 0; rep_ < (DUP_PHASE == (k) ? 2 : 1); ++rep_, (DUP_PHASE == (k) ? xcd_barrier(bar) : (void)0))
#define IDX() int tid = threadIdx.x, bid = blockIdx.x, G = gridDim.x; asm volatile("" : "+v"(tid)); asm volatile("" : "+s"(bid), "+s"(G)); \
    const int lane = tid & 63, wave = __builtin_amdgcn_readfirstlane(tid >> 6), gw = bid * NWAVES + wave, NGW = G * NWAVES; (void)lane; (void)gw; (void)NGW; (void)wave
#define EN(b) ((PHM >> (b)) & 1)
#define SEAM(k) do { if (N_LAUNCH_MODE == 0 && IN(k) && IN((k) + 1)) xcd_barrier(bar); } while (0)

    REP(0) if (IN(0) && EN(0)) { IDX();
        { unsigned char* ws = ARG_WS(); p0_weights(ARG_IN(A_WIN), ARG_IN(A_WOUT), ARG_IN(A_WGATE), ARG_IN(A_WUP), ARG_IN(A_WDOWN), ws, lds + wave * 16384, gw, NGW, lane); }
        __syncthreads();
        { unsigned char* ws = ARG_WS(); p0_mod(ARG_IN(A_C), ARG_IN(A_ADAW), ARG_IN(A_ADAB), WSP(float, WS_MOD), lds, bid, G, tid, wave, lane); }
        __syncthreads();
        { unsigned char* ws = ARG_WS(); p0_cmpw(ARG_IN(A_W1), ARG_IN(A_W2), ARG_IN(A_POS), ws, lds, gw, NGW, bid, G, wave, lane); }
    }
    SEAM(0);
#pragma unroll 1
    for (int layer = 0; layer < DEPTH; ++layer) {
        const int pb = 1 + layer * NPL;
        REP(1) if (IN(pb + 0) && EN(1)) { IDX(); unsigned char* ws = ARG_WS(); const float* mod = WSP(float, WS_MOD) + (size_t)layer * BATCH * NADA;
            if (layer == 0) norm_mod_rows(ARG_IN(A_X), ARG_IN(A_GMIX) + (size_t)layer * DM, mod + 0, mod + DM, WSP(bf16, WS_U), gw, NGW, lane);
            else norm_mod_rows_b(WSP(bf16, WS_H), ARG_IN(A_GMIX) + (size_t)layer * DM, mod + 0, mod + DM, WSP(bf16, WS_U), gw, NGW, lane); }
        SEAM(pb + 0);
        REP(2) if (IN(pb + 1) && EN(2)) { IDX(); unsigned char* ws = ARG_WS();
            pg8::Gemm g{WSP(bf16, WS_U), WSP(bf16, WS_W + (size_t)layer * W_LAYER + W_IN), M, NINP, DM}; pg8::StaticOrder S; S.init(M, NINP, G, bid);
            pg8::EpiBf16 E{WSP(bf16, WS_PROJ), NINP}; pg8::gemm_phase<pg8::EpiBf16, pg8::StaticOrder, true, true>(lds, g, S, E); }
        SEAM(pb + 1);
        REP(3) if (IN(pb + 2) && EN(3)) { IDX(); unsigned char* ws = ARG_WS();
            pre_attn(WSP(bf16, WS_PROJ), ARG_IN(A_FBIAS) + layer * 7, ws, layer, lds, bid, G, gw, NGW, wave, lane); }
        SEAM(pb + 2);
        REP(4) if (IN(pb + 3) && EN(4)) { IDX(); unsigned char* ws = ARG_WS(); for (int pair = bid; pair < 256; pair += G) nsa_select_coop(WSP(bf16, WS_PROJ), WSP(bf16, WS_KC), WSP(unsigned long long, WS_SEL), lds, pair, tid); }
        SEAM(pb + 3);
        if (IN(pb + 4) && EN(5)) for (int rep = 0; rep < (DUP_PHASE == 5 ? 2 : 1); ++rep, (DUP_PHASE == 5 ? xcd_barrier(bar) : (void)0)) { IDX();
            attention_phase<ATTM>(layer, lane, rep, lds, wave); }
        SEAM(pb + 4);
        REP(6) if (IN(pb + 5) && EN(6)) { IDX(); unsigned char* ws = ARG_WS(); const float* mod = WSP(float, WS_MOD) + (size_t)layer * BATCH * NADA;
            pg8::Gemm g{WSP(bf16, WS_O), WSP(bf16, WS_W + (size_t)layer * W_LAYER + W_OUT), M, DM, DM}; pg8::StaticOrder S; S.init(M, DM, G, bid);
            pg8::EpiResidB E{layer == 0 ? (const void*)ARG_IN(A_X) : (const void*)WSP(bf16, WS_H), rep_ ? WSP(bf16, WS_PROJ) : WSP(bf16, WS_H), DM, mod + 2 * DM, NADA, layer == 0 ? 1 : 0}; pg8::gemm_phase<pg8::EpiResidB, pg8::StaticOrder, false, true>(lds, g, S, E); }
        SEAM(pb + 5);
        if (IN(pb + 6) && EN(7)) { IDX(); unsigned char* ws = ARG_WS(); const float* mod = WSP(float, WS_MOD) + (size_t)layer * BATCH * NADA;
            norm_mod_rows_b(WSP(bf16, WS_H), ARG_IN(A_GFFN) + (size_t)layer * DM, mod + 3 * DM, mod + 4 * DM, WSP(bf16, WS_U), gw, NGW, lane); }
        SEAM(pb + 6);
        REP(8) if (IN(pb + 7) && EN(8)) { IDX(); unsigned char* ws = ARG_WS();
            pg8::Gemm g{WSP(bf16, WS_U), WSP(bf16, WS_W + (size_t)layer * W_LAYER + W_GU), M, NGU, DM}; pg8::StaticOrder S; S.init(M, NGU, G, bid);
            pg8::EpiSwiglu E{WSP(bf16, WS_ACT), DFF}; pg8::gemm_phase<pg8::EpiSwiglu, pg8::StaticOrder, true, true>(lds, g, S, E); }
        SEAM(pb + 7);
        REP(9) if (IN(pb + 8) && EN(9)) { IDX(); unsigned char* ws = ARG_WS(); const float* mod = WSP(float, WS_MOD) + (size_t)layer * BATCH * NADA;
            pg8::Gemm g{WSP(bf16, WS_ACT), WSP(bf16, WS_W + (size_t)layer * W_LAYER + W_D), M, DM, DFF}; pg8::StaticOrder S; S.init(M, DM, G, bid);
            pg8::EpiResidB E{(const void*)WSP(bf16, WS_H), rep_ ? WSP(bf16, WS_PROJ) : WSP(bf16, WS_H), DM, mod + 5 * DM, NADA, 0}; pg8::gemm_phase<pg8::EpiResidB, pg8::StaticOrder, false, true>(lds, g, S, E); }
        SEAM(pb + 8);
    }
    if (IN(NPH - 1) && EN(10)) { IDX(); unsigned char* ws = ARG_WS(); norm_final_rows(WSP(bf16, WS_H), ARG_IN(A_GFINAL), ARG_OUT(), gw, NGW, lane); }
#undef IN
#undef SEAM
}

typedef void (*kern_t)(Args);
#if N_LAUNCH_MODE != 0
static kern_t kern_of(int kind, int am) {
    switch (kind) {
        case 0: return fwd_kernel<1 << 0, 0>; case 1: return fwd_kernel<1 << 1, 0>; case 2: return fwd_kernel<1 << 2, 0>; case 3: return fwd_kernel<1 << 3, 0>; case 4: return fwd_kernel<1 << 4, 0>;
        case 5: return am == 1 ? fwd_kernel<1 << 5, 1> : am == 2 ? fwd_kernel<1 << 5, 2> : am == 4 ? fwd_kernel<1 << 5, 4> : fwd_kernel<1 << 5, 8>;
        case 6: return fwd_kernel<1 << 6, 0>; case 7: return fwd_kernel<1 << 7, 0>; case 8: return fwd_kernel<1 << 8, 0>; case 9: return fwd_kernel<1 << 9, 0>; default: return fwd_kernel<1 << 10, 0>;
    }
}
#endif
extern "C" void kernel_launch(void* const* d_in, const int* in_sizes, int n_in, void* d_out, int out_size, void* d_ws, size_t ws_size, hipStream_t stream) {
    static int grid = 0;
    if (grid == 0) {
        if (n_in != 18 || in_sizes[0] != M * DM || out_size != M * DM || ws_size < WS_END) { fprintf(stderr, "kernel_launch: unexpected shapes (n_in %d, in0 %d, out %d, ws %zu < %zu); nothing launched\n", n_in, n_in > 0 ? in_sizes[0] : -1, out_size, ws_size, (size_t)WS_END); grid = -1; return; }
        int dev = 0, cus = 0;
        if (hipGetDevice(&dev) != hipSuccess || hipDeviceGetAttribute(&cus, hipDeviceAttributeMultiprocessorCount, dev) != hipSuccess) { fprintf(stderr, "kernel_launch: device query failed\n"); grid = -1; return; }
#if N_LAUNCH_MODE == 0
        {
            int per_cu = 0;
            if (hipFuncSetAttribute((const void*)fwd_kernel<0xFFFF, 15>, hipFuncAttributeMaxDynamicSharedMemorySize, LDS_BYTES) != hipSuccess) { fprintf(stderr, "kernel_launch: hipFuncSetAttribute failed\n"); grid = -1; return; }
            if (hipOccupancyMaxActiveBlocksPerMultiprocessor(&per_cu, (const void*)fwd_kernel<0xFFFF, 15>, NWAVES * 64, LDS_BYTES) != hipSuccess || per_cu < 1)
                fprintf(stderr, "kernel_launch: note: occupancy query reports %d workgroups per CU\n", per_cu);
        }
#else
        for (int k = 0; k <= 10; ++k) for (int am = 1; am <= 8; am <<= 1)
            if (hipFuncSetAttribute((const void*)kern_of(k, am), hipFuncAttributeMaxDynamicSharedMemorySize, LDS_BYTES) != hipSuccess) { fprintf(stderr, "kernel_launch: hipFuncSetAttribute failed\n"); grid = -1; return; }
#endif
        (void)hipGetLastError();
        grid = cus;
    }
    if (grid < 0) return;
    if (hipMemsetAsync((char*)d_ws + WS_CTL, 0, CTL_ZERO_BYTES, stream) != hipSuccess) { fprintf(stderr, "kernel_launch: hipMemsetAsync failed\n"); return; }
    Args a{};
    for (int i = 0; i < 18; ++i) a.in[i] = (const float*)d_in[i];
    a.out = (float*)d_out; a.ws = (unsigned char*)d_ws;
#if N_LAUNCH_MODE == 0
    {
        a.ph_lo = 0; a.ph_hi = NPH;
        hipLaunchKernelGGL((fwd_kernel<0xFFFF, 15>), dim3(grid), dim3(NWAVES * 64), LDS_BYTES, stream, a);
        const hipError_t le = hipPeekAtLastError();
        if (le != hipSuccess) fprintf(stderr, "kernel_launch: launch failed: %s\n", hipGetErrorName(le));
    }
#else
    {
        for (int p = 0; p < NPH; ++p) { a.ph_lo = p; a.ph_hi = p + 1;
            const int kind = p == 0 ? 0 : (p == NPH - 1 ? 10 : 1 + (p - 1) % NPL);
            for (int am = 1; am <= (kind == 5 ? 8 : 1); am <<= 1) {
                hipLaunchKernelGGL(kern_of(kind, am), dim3(grid), dim3(NWAVES * 64), LDS_BYTES, stream, a);
                const hipError_t le = hipPeekAtLastError();
                if (le != hipSuccess) { fprintf(stderr, "kernel_launch: launch %d failed: %s\n", p, hipGetErrorName(le)); return; } } }
    }
#endif
}
```
